# Optimizing an MI355X kernel written in HIP

```python
import jax, jax.numpy as jnp
from jax import lax
import numpy as np

D_MODEL = 2048
BATCH = 2
SEQ = 8192
DEPTH = 2

GRID_W = 64
CTX_LEN = 256
N_MIXERS = 2
N_RET_LAYERS = (DEPTH + 1) // 2
N_POOL_LAYERS = DEPTH // 2
RET_HEADS = 8
QK_HEAD_DIM = D_MODEL // RET_HEADS
V_HEAD_DIM = 2 * QK_HEAD_DIM
QK_DIM = RET_HEADS * QK_HEAD_DIM
V_DIM = RET_HEADS * V_HEAD_DIM
RET_IN_DIM = 2 * QK_DIM + 2 * V_DIM
RET_CHUNK = 128
ROPE_BASE = 10000.0
POOL_WINDOWS = (2, 4, 8, 16)
POOL_GROUPS = 4
POOL_GROUP_DIM = D_MODEL // POOL_GROUPS
N_EXPERTS = 64
TOP_K = 8
N_EXPERT_GROUPS = 8
TOPK_GROUPS = 4
EXPERT_DIM = 512
SHARED_DIM = 512
ROUTED_SCALE = 2.5
MOE_BLOCK = 128
N_MOD = 6
LN_EPS = 1e-5
DEEPNORM_ALPHA = (2.0 * DEPTH) ** 0.25
DEEPNORM_BETA = (8.0 * DEPTH) ** -0.25

kernel_name = 'hybrid_retention_pool_moe_dit'

f32 = jnp.float32


def layer_norm(x, g, b):
    xf = x.astype(f32)
    mu = xf.mean(-1, keepdims=True)
    var = jnp.square(xf - mu).mean(-1, keepdims=True)
    return ((xf - mu) * lax.rsqrt(var + LN_EPS) * g.astype(f32) + b.astype(f32)).astype(x.dtype)


def _axial_rope(t, row, col):
    n_freq = QK_HEAD_DIM // 4
    freqs = ROPE_BASE ** (-jnp.arange(n_freq, dtype=f32) / n_freq)
    ang = jnp.concatenate([row[:, None] * freqs, col[:, None] * freqs], axis=-1)
    cos, sin = jnp.cos(ang), jnp.sin(ang)
    tp = t.reshape(t.shape[:-1] + (QK_HEAD_DIM // 2, 2))
    t1, t2 = tp[..., 0], tp[..., 1]
    return jnp.stack([t1 * cos - t2 * sin, t1 * sin + t2 * cos], axis=-1).reshape(t.shape)


def _retention_chunkwise(q, k, v, log_decay, s0, include_diag):
    b, h, n, _ = q.shape
    nc = n // RET_CHUNK
    pos = jnp.arange(RET_CHUNK, dtype=f32)
    rel = pos[:, None] - pos[None, :]
    mask = rel >= 0 if include_diag else rel > 0
    decay_in = jnp.where(mask, jnp.exp(log_decay[:, None, None] * jnp.maximum(rel, 0.0)), 0.0)
    q_dec = jnp.exp(log_decay[:, None] * (pos + 1.0))
    k_dec = jnp.exp(log_decay[:, None] * (RET_CHUNK - 1.0 - pos))
    chunk_dec = jnp.exp(log_decay * RET_CHUNK)

    def to_chunks(t):
        return jnp.moveaxis(t.reshape(b, h, nc, RET_CHUNK, t.shape[-1]), 2, 0)

    def step(s, qkv):
        qc, kc, vc = qkv
        scores = jnp.einsum('bhik,bhjk->bhij', qc, kc) * decay_in
        o = (jnp.einsum('bhij,bhjv->bhiv', scores, vc)
             + jnp.einsum('bhik,bhkv->bhiv', qc * q_dec[:, :, None], s))
        s = s * chunk_dec[:, None, None] + jnp.einsum('bhjk,bhjv->bhkv', kc * k_dec[:, :, None], vc)
        return s, o

    s_final, o = lax.scan(step, s0, (to_chunks(q), to_chunks(k), to_chunks(v)))
    o = jnp.moveaxis(o, 0, 2).reshape(b, h, n, v.shape[-1])
    return o, s_final


def _ret_project(h, w_in):
    b, n, _ = h.shape
    p = jnp.einsum('bnd,de->bne', h, w_in).astype(f32)
    q, k, v, g = jnp.split(p, [QK_DIM, 2 * QK_DIM, 2 * QK_DIM + V_DIM], axis=-1)

    def heads(t, hd):
        return t.reshape(b, n, RET_HEADS, hd).transpose(0, 2, 1, 3)

    return heads(q, QK_HEAD_DIM), heads(k, QK_HEAD_DIM) * QK_HEAD_DIM ** -0.5, heads(v, V_HEAD_DIM), g


def _ret_output(o, g, w_out):
    mu = o.mean(-1, keepdims=True)
    var = jnp.square(o - mu).mean(-1, keepdims=True)
    o = (o - mu) * lax.rsqrt(var + LN_EPS)
    b, h, n, dv = o.shape
    o = o.transpose(0, 2, 1, 3).reshape(b, n, h * dv)
    return jnp.einsum('bne,ed->bnd', (jax.nn.silu(g) * o).astype(w_out.dtype), w_out)


def retention_mixer(hl, hc, w_in, w_out, raw_fwd, raw_bwd, row, col, with_ctx_out):
    ld_fwd = jax.nn.log_sigmoid(raw_fwd.astype(f32))
    ld_bwd = jax.nn.log_sigmoid(raw_bwd.astype(f32))
    ql, kl, vl, gl = _ret_project(hl, w_in)
    ql = _axial_rope(ql, row, col)
    kl = _axial_rope(kl, row, col)
    qc, kc, vc, gc = _ret_project(hc, w_in)
    s0 = jnp.zeros((hl.shape[0], RET_HEADS, QK_HEAD_DIM, V_HEAD_DIM), f32)

    def flip(t):
        return jnp.flip(t, axis=2)

    oc_f, sc_f = _retention_chunkwise(qc, kc, vc, ld_fwd, s0, True)
    oc_b, sc_b = _retention_chunkwise(flip(qc), flip(kc), flip(vc), ld_bwd, s0, False)
    ol_f, _ = _retention_chunkwise(ql, kl, vl, ld_fwd, sc_f, True)
    ol_b, _ = _retention_chunkwise(flip(ql), flip(kl), flip(vl), ld_bwd, sc_b, False)
    yl = _ret_output(ol_f + flip(ol_b), gl, w_out).astype(hl.dtype)
    yc = _ret_output(oc_f + flip(oc_b), gc, w_out).astype(hc.dtype) if with_ctx_out else None
    return yl, yc


def _centred_mean_minus_self(t, window):
    n = t.shape[-2]
    tf = t.astype(f32)
    cs = jnp.concatenate([jnp.zeros_like(tf[..., :1, :]), jnp.cumsum(tf, axis=-2)], axis=-2)
    idx = jnp.arange(n)
    lo = jnp.clip(idx - window // 2, 0, n)
    hi = jnp.clip(idx + window // 2, 0, n)
    total = jnp.take(cs, hi, axis=-2) - jnp.take(cs, lo, axis=-2)
    return total / (hi - lo).astype(f32)[:, None] - tf


def pool_mixer(h, w_pool, scale):
    parts = [_centred_mean_minus_self(h[..., g * POOL_GROUP_DIM:(g + 1) * POOL_GROUP_DIM], POOL_WINDOWS[g])
             for g in range(POOL_GROUPS)]
    p = jnp.stack(parts, axis=-2).astype(h.dtype)
    y = jnp.einsum('...gc,gce->...ge', p, w_pool)
    return y.reshape(h.shape) * scale


def _swiglu(h, w_gate, w_up, w_down):
    return jnp.dot(jax.nn.silu(jnp.dot(h, w_gate)) * jnp.dot(h, w_up), w_down)


def moe_ffn(h, router_w, router_b, w_gate, w_up, w_down, sh_gate, sh_up, sh_down):
    n_tok, dm = h.shape
    scores = jax.nn.sigmoid(jnp.dot(h.astype(f32), router_w.astype(f32)))
    biased = scores + router_b.astype(f32)
    grouped = biased.reshape(n_tok, N_EXPERT_GROUPS, N_EXPERTS // N_EXPERT_GROUPS)
    group_score = lax.top_k(grouped, 2)[0].sum(-1)
    _, gidx = lax.top_k(group_score, TOPK_GROUPS)
    gmask = jax.nn.one_hot(gidx, N_EXPERT_GROUPS, dtype=f32).sum(1) > 0
    emask = jnp.repeat(gmask, N_EXPERTS // N_EXPERT_GROUPS, axis=1)
    _, eidx = lax.top_k(jnp.where(emask, biased, -jnp.inf), TOP_K)
    gate = jnp.take_along_axis(scores, eidx, axis=-1)
    gate = gate / gate.sum(-1, keepdims=True) * ROUTED_SCALE

    n_assign = n_tok * TOP_K
    e_flat = eidx.reshape(n_assign)
    tok_flat = jnp.repeat(jnp.arange(n_tok, dtype=jnp.int32), TOP_K)
    g_flat = gate.reshape(n_assign)
    order = jnp.argsort(e_flat)
    e_s, tok_s, g_s = e_flat[order], tok_flat[order], g_flat[order]
    counts = jnp.bincount(e_flat, length=N_EXPERTS)
    padded = (counts + MOE_BLOCK - 1) // MOE_BLOCK * MOE_BLOCK
    grp_start = jnp.cumsum(counts) - counts
    pad_end = jnp.cumsum(padded)
    pad_start = pad_end - padded
    slot = pad_start[e_s] + jnp.arange(n_assign, dtype=jnp.int32) - grp_start[e_s]
    n_slots = n_assign + N_EXPERTS * MOE_BLOCK
    n_blocks = n_slots // MOE_BLOCK
    tok_buf = jnp.full((n_slots,), n_tok, jnp.int32).at[slot].set(tok_s)
    g_buf = jnp.zeros((n_slots,), f32).at[slot].set(g_s)
    blk_expert = jnp.minimum(jnp.searchsorted(pad_end, jnp.arange(n_blocks) * MOE_BLOCK, side='right'),
                             N_EXPERTS - 1)
    h_pad = jnp.concatenate([h, jnp.zeros((1, dm), h.dtype)], axis=0)

    def block(y, inp):
        tok_b, g_b, e_b = inp
        a = _swiglu(h_pad[tok_b], w_gate[e_b], w_up[e_b], w_down[e_b])
        return y.at[tok_b].add((a * g_b[:, None]).astype(y.dtype)), None

    y, _ = lax.scan(block, jnp.zeros((n_tok + 1, dm), h.dtype),
                    (tok_buf.reshape(n_blocks, MOE_BLOCK), g_buf.reshape(n_blocks, MOE_BLOCK), blk_expert))
    return y[:n_tok] + _swiglu(h, sh_gate, sh_up, sh_down).astype(h.dtype)


def setup_inputs(seed: int = 0) -> dict:
    key = jax.random.key(seed)
    ks = jax.random.split(key, 24)

    def nrm(k, shape, s):
        return jax.random.normal(k, shape, f32) * s

    dm = D_MODEL
    beta = DEEPNORM_BETA
    col_scale = jnp.concatenate([jnp.ones((2 * QK_DIM,), f32), jnp.full((V_DIM,), beta, f32),
                                 jnp.ones((V_DIM,), f32)])
    decay_base = jnp.log(2.0 ** (5.0 + jnp.arange(RET_HEADS, dtype=f32)) - 1.0)
    return {
        'x': nrm(ks[0], (BATCH, SEQ, dm), 1.0),
        'c': nrm(ks[1], (BATCH, dm), 1.0),
        'ctx': nrm(ks[2], (BATCH, CTX_LEN, dm), 1.0),
        'c_ctx': nrm(ks[3], (dm,), 1.0),
        'ada_w': nrm(ks[4], (DEPTH, dm, N_MOD * dm), 0.5 * dm ** -0.5),
        'ada_b': nrm(ks[5], (DEPTH, N_MOD * dm), 0.01),
        'ln_mix_g': 1.0 + nrm(ks[6], (DEPTH, dm), 0.02),
        'ln_mix_b': nrm(ks[7], (DEPTH, dm), 0.02),
        'ln_ffn_g': 1.0 + nrm(ks[8], (DEPTH, dm), 0.02),
        'ln_ffn_b': nrm(ks[9], (DEPTH, dm), 0.02),
        'ret_w_in': nrm(ks[10], (N_RET_LAYERS, dm, RET_IN_DIM), dm ** -0.5) * col_scale,
        'ret_w_out': nrm(ks[11], (N_RET_LAYERS, V_DIM, dm), beta * V_DIM ** -0.5),
        'ret_decay_fwd': decay_base + nrm(ks[12], (N_RET_LAYERS, RET_HEADS), 0.1),
        'ret_decay_bwd': decay_base + nrm(ks[13], (N_RET_LAYERS, RET_HEADS), 0.1),
        'pool_w': nrm(ks[14], (N_POOL_LAYERS, POOL_GROUPS, POOL_GROUP_DIM, POOL_GROUP_DIM),
                      beta * POOL_GROUP_DIM ** -0.5),
        'pool_scale': 1.0 + nrm(ks[15], (N_POOL_LAYERS, dm), 0.1),
        'router_w': nrm(ks[16], (DEPTH, dm, N_EXPERTS), dm ** -0.5),
        'router_b': nrm(ks[17], (DEPTH, N_EXPERTS), 0.01),
        'exp_w_gate': nrm(ks[18], (DEPTH, N_EXPERTS, dm, EXPERT_DIM), dm ** -0.5),
        'exp_w_up': nrm(ks[19], (DEPTH, N_EXPERTS, dm, EXPERT_DIM), dm ** -0.5),
        'exp_w_down': nrm(ks[20], (DEPTH, N_EXPERTS, EXPERT_DIM, dm), beta * EXPERT_DIM ** -0.5),
        'sh_w_gate': nrm(ks[21], (DEPTH, dm, SHARED_DIM), dm ** -0.5),
        'sh_w_up': nrm(ks[22], (DEPTH, dm, SHARED_DIM), dm ** -0.5),
        'sh_w_down': nrm(ks[23], (DEPTH, SHARED_DIM, dm), beta * SHARED_DIM ** -0.5),
    }


def reference(x, c, ctx, c_ctx, ada_w, ada_b, ln_mix_g, ln_mix_b, ln_ffn_g, ln_ffn_b,
              ret_w_in, ret_w_out, ret_decay_fwd, ret_decay_bwd, pool_w, pool_scale,
              router_w, router_b, exp_w_gate, exp_w_up, exp_w_down, sh_w_gate, sh_w_up, sh_w_down):
    b, n_lat, dm = x.shape
    n_ctx = ctx.shape[1]
    rows = n_lat // GRID_W
    pos = jnp.arange(n_lat, dtype=jnp.int32)
    row = (pos // GRID_W).astype(f32)
    col = (pos % GRID_W).astype(f32)
    silu_c = jax.nn.silu(c.astype(f32))
    silu_cc = jax.nn.silu(c_ctx.astype(f32))
    xl, xc = x, ctx
    for i in range(DEPTH):
        ctx_out = i < DEPTH - 1
        w_a, b_a = ada_w[i].astype(f32), ada_b[i].astype(f32)
        mod_l = (jnp.dot(silu_c, w_a) + b_a).astype(x.dtype)[:, None, :]
        mod_c = (jnp.dot(silu_cc, w_a) + b_a).astype(x.dtype)
        sh1_l, sc1_l, g1_l, sh2_l, sc2_l, g2_l = jnp.split(mod_l, N_MOD, axis=-1)
        sh1_c, sc1_c, g1_c, sh2_c, sc2_c, g2_c = jnp.split(mod_c, N_MOD, axis=-1)

        hl = xl * (1.0 + sc1_l) + sh1_l
        hc = xc * (1.0 + sc1_c) + sh1_c
        j = i // N_MIXERS
        if i % N_MIXERS == 0:
            yl, yc = retention_mixer(hl, hc, ret_w_in[j], ret_w_out[j], ret_decay_fwd[j], ret_decay_bwd[j],
                                     row, col, ctx_out)
        else:
            yl = pool_mixer(hl.reshape(b, rows, GRID_W, dm), pool_w[j], pool_scale[j]).reshape(b, n_lat, dm)
            yc = pool_mixer(hc, pool_w[j], pool_scale[j]) if ctx_out else None
        xl = layer_norm(DEEPNORM_ALPHA * xl + g1_l * yl, ln_mix_g[i], ln_mix_b[i])
        if ctx_out:
            xc = layer_norm(DEEPNORM_ALPHA * xc + g1_c * yc, ln_mix_g[i], ln_mix_b[i])

        h_tok = (xl * (1.0 + sc2_l) + sh2_l).reshape(b * n_lat, dm)
        if ctx_out:
            h_tok = jnp.concatenate([h_tok, (xc * (1.0 + sc2_c) + sh2_c).reshape(b * n_ctx, dm)], axis=0)
        f = moe_ffn(h_tok, router_w[i], router_b[i], exp_w_gate[i], exp_w_up[i], exp_w_down[i],
                    sh_w_gate[i], sh_w_up[i], sh_w_down[i])
        xl = layer_norm(DEEPNORM_ALPHA * xl + g2_l * f[:b * n_lat].reshape(b, n_lat, dm),
                        ln_ffn_g[i], ln_ffn_b[i])
        if ctx_out:
            xc = layer_norm(DEEPNORM_ALPHA * xc + g2_c * f[b * n_lat:].reshape(b, n_ctx, dm),
                            ln_ffn_g[i], ln_ffn_b[i])
    return xl
```

```cpp
#include <hip/hip_runtime.h>
#include <cstdio>
#include <cstdint>

#define GAS __attribute__((address_space(1)))
#define LAS __attribute__((address_space(3)))
typedef unsigned short bf16;
typedef short bf16x8 __attribute__((ext_vector_type(8)));
typedef float f32x4 __attribute__((ext_vector_type(4)));
typedef float f32x2 __attribute__((ext_vector_type(2)));
typedef unsigned u32x4 __attribute__((ext_vector_type(4)));
typedef unsigned u32x2 __attribute__((ext_vector_type(2)));

#ifndef MK_PER_PHASE
#define MK_PER_PHASE 0
#endif
#ifndef FAST_MASK
#define FAST_MASK 0x7f
#endif
#ifndef CONV_P2
#define CONV_P2 6
#endif
#ifndef CONV_P9
#define CONV_P9 4
#endif
#ifndef CONV_P10
#define CONV_P10 6
#endif
#ifndef W13_SPLIT
#define W13_SPLIT 24000
#endif
#ifndef PH_LIMIT
#define PH_LIMIT 18
#endif

constexpr int D = 2048, NB = 2, SEQ = 8192, NLAT = NB * SEQ, CTXL = 256, NCTX = NB * CTXL, NTOK0 = NLAT + NCTX;
constexpr int NH = 8, DKH = 256, DVH = 512, VD = 4096, RIN = 12288;
constexpr int NE = 64, NE1 = 65, ED = 512;
constexpr int MODW = 6 * D;
constexpr float ALPHA = 1.41421356237309515f, LN_EPS = 1e-5f, ROUTED_SCALE = 2.5f;
constexpr int CAP = 16896;
constexpr int NPANEL0 = NTOK0 / 256;
constexpr int NIDX = NPANEL0 * NH;
constexpr int NQK = 64 * NH;
constexpr int NPH = 18;

constexpr size_t MiB = 1u << 20;
constexpr size_t WS_CTL = 0, CTL_ZERO_BYTES = 1 * MiB;
constexpr size_t WS_MOD = 1 * MiB;
constexpr size_t WS_ROPE = 1 * MiB + 512 * 1024;
constexpr size_t WS_L2G = WS_ROPE + 128 * 1024;
constexpr size_t WS_RW = 2 * MiB;
constexpr size_t WS_TOKE = 4 * MiB, WS_TOKP = 5 * MiB;
constexpr size_t WS_ROWL = 6 * MiB, WS_SLOTG = 11 * MiB;
constexpr size_t WS_WIN = 16 * MiB, WS_WOUT = 64 * MiB, WS_WPOOL = 80 * MiB;
constexpr size_t WS_W13_0 = 82 * MiB, WS_W2_0 = 342 * MiB;
constexpr size_t WS_HB = 472 * MiB, WS_XL = 538 * MiB, WS_R1 = 670 * MiB, WS_S = 802 * MiB;
constexpr size_t WS_KR = WS_S, WS_KDTF = WS_S + 66 * MiB, WS_KDTB = WS_S + 132 * MiB, WS_PQ = WS_S + 198 * MiB, WS_VS = WS_S + 396 * MiB;
constexpr size_t WS_U = WS_S + 792 * MiB, WS_GS = WS_S + 1056 * MiB, WS_O = WS_U, WS_A2 = WS_S;
constexpr size_t WS_W13_1 = WS_S, WS_W2_1 = WS_S + 260 * MiB, WS_ACT = WS_S + 390 * MiB, WS_Y = WS_S + 556 * MiB;
constexpr size_t WS_END = 2048 * MiB;
static_assert(WS_GS + 132 * MiB <= WS_END && WS_Y + 658 * MiB <= WS_END && WS_ACT + 166 * MiB <= WS_Y, "ws map");
constexpr size_t PQ_E = 256 * 768, VS_E = 512 * 768, KR_E = 256 * 256, U_E = 512 * 256;
constexpr size_t W13_E = 1024 * 2048, W2_E = 2048 * 512;
constexpr int CW_CNT = 8192;
constexpr int CW_BAR = 4096;

constexpr int RING_BYTES = 131072;
constexpr int SCR_BYTES = 8 * 16640;
constexpr int LDSCTL_OFF = 136 * 1024;
constexpr int LDS_BYTES = 147456;
static_assert(SCR_BYTES <= LDSCTL_OFF, "lds");
constexpr int NWAVES = 8;

#define RLX_AGENT __ATOMIC_RELAXED, __HIP_MEMORY_SCOPE_AGENT
#define LDS_WAIT() asm volatile("s_waitcnt lgkmcnt(0)" ::: "memory")
#define VM_WAIT() asm volatile("s_waitcnt vmcnt(0)" ::: "memory")

__device__ __forceinline__ unsigned cvt_pk_bf16(float lo, float hi) { unsigned r; asm volatile("v_cvt_pk_bf16_f32 %0, %1, %2" : "=v"(r) : "v"(lo), "v"(hi)); return r; }
__device__ __forceinline__ unsigned f2bf(float f) { unsigned u = __builtin_bit_cast(unsigned, f); return (u + 0x7fffu + ((u >> 16) & 1u)) >> 16; }
__device__ __forceinline__ float bf2f(unsigned b) { return __builtin_bit_cast(float, b << 16); }
__device__ __forceinline__ u32x4 pack8(f32x4 a, f32x4 b) { u32x4 w; w.x = cvt_pk_bf16(a[0], a[1]); w.y = cvt_pk_bf16(a[2], a[3]); w.z = cvt_pk_bf16(b[0], b[1]); w.w = cvt_pk_bf16(b[2], b[3]); return w; }
__device__ __forceinline__ float silu_f(float x) { return x * __builtin_amdgcn_rcpf(1.0f + __expf(-x)); }
__device__ __forceinline__ float wave_sum(float v) {
#pragma unroll
    for (int o = 1; o < 64; o <<= 1) v += __shfl_xor(v, o);
    return v;
}
__device__ __forceinline__ float wave_max(float v) {
#pragma unroll
    for (int o = 1; o < 64; o <<= 1) v = fmaxf(v, __shfl_xor(v, o));
    return v;
}

#define XB_TMO      128
#define XB_XCNT(j)  (256  + 64 * (j))
#define XB_XSUB(j)  (1280 + 64 * (j))
#define XB_XGEN(j)  (2304 + 64 * (j))
#define XB_TOP      3328
#define XB_TOPGEN   3392
#define XCD_BAR_WORDS 3456
#define XB_SPIN_CAP (1u << 18)
__device__ __forceinline__ unsigned xb_ld(unsigned* p)              { return __hip_atomic_load(p, __ATOMIC_RELAXED, __HIP_MEMORY_SCOPE_AGENT); }
__device__ __forceinline__ unsigned xb_add(unsigned* p, unsigned v) { return __hip_atomic_fetch_add(p, v, __ATOMIC_RELAXED, __HIP_MEMORY_SCOPE_AGENT); }
__device__ __forceinline__ unsigned xb_xcc_id() { return (unsigned)__builtin_amdgcn_s_getreg((3 << 11) | 20) & 0xFu; }
#define XB_SPIN(cond, bar) do { unsigned _sp = 0; while (cond) { __builtin_amdgcn_s_sleep(1); \
    if ((++_sp & 255u) == 0u) { if (xb_ld(&(bar)[XB_TMO])) break; if (_sp > XB_SPIN_CAP) { atomicAdd(&(bar)[XB_TMO], 1u); break; } } } } while (0)
struct XcdBarrier { unsigned* bar; unsigned x; volatile LAS unsigned* st; };
__device__ __forceinline__ XcdBarrier xcd_barrier_post(unsigned* bar, volatile LAS unsigned* st) {
    XcdBarrier b; b.bar = bar; b.x = xb_xcc_id(); b.st = st;
    if (threadIdx.x == 0) (void)xb_add(&bar[XB_XCNT(b.x)], 1u);
    return b;
}
__device__ __forceinline__ void xcd_barrier_complete(unsigned* bar, unsigned x, unsigned& nloc, unsigned& nx) {
    const unsigned G = gridDim.x * gridDim.y * gridDim.z;
    unsigned sum, cnt, mine, sp = 0u;
    for (;;) {
        sum = 0u; cnt = 0u; mine = 0u;
#pragma unroll
        for (unsigned j = 0; j < 16; ++j) { const unsigned c = xb_ld(&bar[XB_XCNT(j)]); sum += c; cnt += (c > 0u) ? 1u : 0u; mine = (j == x) ? c : mine; }
        if (sum == G) break;
        __builtin_amdgcn_s_sleep(1);
        if ((++sp & 255u) == 0u) { if (xb_ld(&bar[XB_TMO])) break; if (sp > XB_SPIN_CAP) { atomicAdd(&bar[XB_TMO], 1u); break; } }
    }
    nloc = mine > 0u ? mine : 1u; nx = cnt > 0u ? cnt : 1u;
}
__device__ __forceinline__ void xcd_barrier(const XcdBarrier& b) {
    asm volatile("s_waitcnt vmcnt(0)" ::: "memory");
    __syncthreads();
    if (threadIdx.x == 0) {
        unsigned* bar = b.bar;
        __builtin_amdgcn_s_waitcnt(0);
        unsigned nloc = b.st[0], nx = b.st[1];
        if (nloc == 0u) { xcd_barrier_complete(bar, b.x, nloc, nx); b.st[0] = nloc; b.st[1] = nx; }
        const unsigned old = xb_add(&bar[XB_XSUB(b.x)], 1u);
        const unsigned gen = old / nloc;
        if (old + 1u == (gen + 1u) * nloc) {
            __builtin_amdgcn_fence(__ATOMIC_RELEASE, "agent");
            asm volatile("s_waitcnt vmcnt(0)" ::: "memory");
            const unsigned og = xb_add(&bar[XB_TOP], 1u);
            const unsigned tg = og / nx;
            if (og + 1u == (tg + 1u) * nx) xb_add(&bar[XB_TOPGEN], 1u);
            else XB_SPIN(xb_ld(&bar[XB_TOPGEN]) == tg, bar);
            __builtin_amdgcn_fence(__ATOMIC_ACQUIRE, "agent");
            xb_add(&bar[XB_XGEN(b.x)], 1u);
            asm volatile("s_waitcnt vmcnt(0)" ::: "memory");
        } else {
            XB_SPIN(xb_ld(&bar[XB_XGEN(b.x)]) == gen, bar);
            __builtin_amdgcn_fence(__ATOMIC_ACQUIRE, "agent");
            asm volatile("s_waitcnt vmcnt(0)" ::: "memory");
        }
    }
    __syncthreads();
}

namespace pg8 {
constexpr int BM = 256, BK = 64, HALF = 128, HTB = HALF * BK * 2, STAGE_BYTES = 8 * HTB;
__host__ __device__ __forceinline__ int lds_byte(int r, int c) { const int st = (r >> 4) * 2 + (c >> 5), rr = r & 15, cc = c & 31, ob = rr * 64 + cc * 2; return st * 1024 + (ob ^ (((ob >> 9) & 1) << 5)); }
__host__ __device__ __forceinline__ void stage_rc(int b, int& R, int& C) { const int st = b / 1024, sb = b % 1024, swz = sb ^ (((sb >> 9) & 1) << 5); R = (st >> 1) * 16 + swz / 64; C = (st & 1) * 32 + (swz % 64) / 2; }
__host__ __device__ __forceinline__ int perm32(int rho) { const int n = rho >> 4, i = rho & 15; return 8 * (i >> 2) + 4 * n + (i & 3); }

struct Unit { const char* a; const char* b; int pm, pn, x0, x1; };
struct Dims { int lda, ldb, K; };

template <class Epi, class Sched, bool GATHER>
__device__ __forceinline__ void gemm_simple(const Dims g, const Sched& S, const Epi& E) {
    const int tid = threadIdx.x, wid = __builtin_amdgcn_readfirstlane(tid >> 6), lane = tid & 63, wr = wid >> 2, wc = wid & 3, fr = lane & 15, fq = lane >> 4;
    Unit u;
    for (int ui = 0; S.next(ui, u); ++ui) {
        f32x4 acc[2][2][4][2];
#pragma unroll
        for (int a = 0; a < 2; ++a)
#pragma unroll
            for (int b = 0; b < 2; ++b)
#pragma unroll
                for (int m = 0; m < 4; ++m)
#pragma unroll
                    for (int n = 0; n < 2; ++n) acc[a][b][m][n] = (f32x4){0.f, 0.f, 0.f, 0.f};
        unsigned aoff[2][4], boff[2][2];
#pragma unroll
        for (int ai = 0; ai < 2; ++ai)
#pragma unroll
            for (int m = 0; m < 4; ++m) { const int R = 128 * ai + 64 * wr + 16 * m + fr; const int row = GATHER ? S.row_of(u, R) : R; aoff[ai][m] = ((unsigned)row * (unsigned)g.lda + (unsigned)fq * 8u) * 2u; }
#pragma unroll
        for (int bj = 0; bj < 2; ++bj)
#pragma unroll
            for (int n = 0; n < 2; ++n) { const int R = 128 * bj + 32 * wc + (Epi::PERM ? perm32(16 * n + fr) : 16 * n + fr); boff[bj][n] = ((unsigned)R * (unsigned)g.ldb + (unsigned)fq * 8u) * 2u; }
        for (int k = 0; k < g.K; k += 32) {
#pragma unroll
            for (int ai = 0; ai < 2; ++ai) {
                bf16x8 At[4];
#pragma unroll
                for (int m = 0; m < 4; ++m) At[m] = *(const bf16x8*)(u.a + aoff[ai][m] + (size_t)k * 2);
#pragma unroll
                for (int bj = 0; bj < 2; ++bj) {
                    bf16x8 Bt[2];
#pragma unroll
                    for (int n = 0; n < 2; ++n) Bt[n] = *(const bf16x8*)(u.b + boff[bj][n] + (size_t)k * 2);
#pragma unroll
                    for (int m = 0; m < 4; ++m)
#pragma unroll
                        for (int n = 0; n < 2; ++n) acc[ai][bj][m][n] = __builtin_amdgcn_mfma_f32_16x16x32_bf16(Bt[n], At[m], acc[ai][bj][m][n], 0, 0, 0);
                    asm volatile("" ::: "memory");
                }
            }
        }
        __syncthreads();
        { int fr2 = fr, fq2 = fq, wr2 = wr, wc2 = wc; asm volatile("" : "+v"(fr2), "+v"(fq2), "+s"(wr2), "+s"(wc2)); E(acc, u, wr2, wc2, fr2, fq2); }
    }
}

template <class Epi, class Sched, bool GATHER>
__device__ __forceinline__ void gemm_fast(LAS unsigned char* lds, const Dims g, const Sched& S, const Epi& E) {
    const int tid = threadIdx.x, wid = __builtin_amdgcn_readfirstlane(tid >> 6), lane = tid & 63, wr = wid >> 2, wc = wid & 3, fr = lane & 15, fq = lane >> 4;
    const int nt = g.K / BK;
    unsigned voffA[2][2], voffB[2];
#pragma unroll
    for (int i = 0; i < 2; ++i) { int R, C; stage_rc(tid * 16 + i * 8192, R, C); const int Rb = Epi::PERM ? ((R & ~31) + perm32(R & 31)) : R;
        voffA[0][i] = (unsigned)(R * g.lda + C) * 2u; voffA[1][i] = (unsigned)((R + HALF) * g.lda + C) * 2u; voffB[i] = (unsigned)(Rb * g.ldb + C) * 2u; }
    const size_t kstep = (size_t)(BK * 2);
    const size_t hstepB = (size_t)HALF * g.ldb * 2;
    const unsigned ldsw = (unsigned)wid * 1024u;
    const int aoff = lds_byte(wr * 64 + fr, fq * 8), boff = lds_byte(wc * 32 + fr, fq * 8);
#define PG8_SA(b, h) (((b) * 2 + (h)) * HTB)
#define PG8_SB(b, h) ((4 + (b) * 2 + (h)) * HTB)
#define PG8_STAGEA(bufoff, gbase, h) do { _Pragma("unroll") for (int _i = 0; _i < 2; ++_i) \
        __builtin_amdgcn_global_load_lds((const unsigned*)((const char*)(gbase) + voffA[h][_i]), (LAS unsigned*)(lds + (bufoff) + ldsw + _i * 8192), 16, 0, 0); } while (0)
#define PG8_STAGEB(bufoff, gbase) do { _Pragma("unroll") for (int _i = 0; _i < 2; ++_i) \
        __builtin_amdgcn_global_load_lds((const unsigned*)((const char*)(gbase) + voffB[_i]), (LAS unsigned*)(lds + (bufoff) + ldsw + _i * 8192), 16, 0, 0); } while (0)
#define PG8_LDA(dst, b, h) do { _Pragma("unroll") for (int m = 0; m < 4; ++m) _Pragma("unroll") for (int k = 0; k < 2; ++k) dst[m][k] = *(const LAS bf16x8*)(lds + PG8_SA(b, h) + aoff + m * 2048 + k * 1024); } while (0)
#define PG8_LDB(dst, b, h) do { _Pragma("unroll") for (int n = 0; n < 2; ++n) _Pragma("unroll") for (int k = 0; k < 2; ++k) dst[n][k] = *(const LAS bf16x8*)(lds + PG8_SB(b, h) + boff + n * 2048 + k * 1024); } while (0)
#define PG8_MMA(ai, bj, At, Bt) do { __builtin_amdgcn_s_setprio(1); _Pragma("unroll") for (int m = 0; m < 4; ++m) _Pragma("unroll") for (int n = 0; n < 2; ++n) _Pragma("unroll") for (int k = 0; k < 2; ++k) \
        acc[ai][bj][m][n] = __builtin_amdgcn_mfma_f32_16x16x32_bf16(Bt[n][k], At[m][k], acc[ai][bj][m][n], 0, 0, 0); __builtin_amdgcn_s_setprio(0); } while (0)
#define PG8_WAIT_V(n) asm volatile("s_waitcnt vmcnt(" #n ")" ::: "memory")
#define PG8_WAIT_L(n) asm volatile("s_waitcnt lgkmcnt(" #n ")" ::: "memory")
#define PG8_BAR __builtin_amdgcn_s_barrier()
#define PG8_SCHED __builtin_amdgcn_sched_barrier(0)
#define PG8_GOFF(uu) do { if constexpr (GATHER) { _Pragma("unroll") for (int _i = 0; _i < 2; ++_i) { int _R, _C; stage_rc((int)threadIdx.x * 16 + _i * 8192, _R, _C); _Pragma("unroll") for (int _h = 0; _h < 2; ++_h) \
        voffA[_h][_i] = ((unsigned)S.row_of(uu, _R + _h * HALF) * (unsigned)g.lda + (unsigned)_C) * 2u; } } } while (0)
    Unit cur, nxt; int ui = 0;
    if (!S.next(0, cur)) return;
    f32x4 acc[2][2][4][2];
#pragma unroll
    for (int a = 0; a < 2; ++a)
#pragma unroll
        for (int b = 0; b < 2; ++b)
#pragma unroll
            for (int m = 0; m < 4; ++m)
#pragma unroll
                for (int n = 0; n < 2; ++n) acc[a][b][m][n] = (f32x4){0.f, 0.f, 0.f, 0.f};
    bf16x8 At[4][2], B0[2][2], B1[2][2];
    const char* cA = cur.a; const char* cB = cur.b;
    PG8_GOFF(cur);
    PG8_STAGEB(PG8_SB(0, 0), cB); PG8_STAGEB(PG8_SB(0, 1), cB + hstepB); PG8_STAGEA(PG8_SA(0, 0), cA, 0); PG8_STAGEA(PG8_SA(0, 1), cA, 1);
    if (wr == 1) PG8_BAR;
    PG8_WAIT_V(2); PG8_BAR;
    PG8_STAGEB(PG8_SB(1, 0), cB + kstep); PG8_STAGEA(PG8_SA(1, 0), cA + kstep, 0); PG8_STAGEB(PG8_SB(1, 1), cB + hstepB + kstep);
    PG8_WAIT_V(6); PG8_BAR;
    for (;;) {
        const bool has_next = S.next(ui + 1, nxt);
        const char* nA = has_next ? nxt.a : cA; const char* nB = has_next ? nxt.b : cB;
        for (int t = 0; t < nt; t += 2) {
            const bool last = (t == nt - 2);
            const char* a1 = cA + (size_t)(t + 1) * kstep;
            const char* a2 = last ? nA : cA + (size_t)(t + 2) * kstep; const char* b2 = last ? nB : cB + (size_t)(t + 2) * kstep;
            const char* a3 = a2 + kstep; const char* b3 = b2 + kstep;
            PG8_LDB(B0, 0, 0); PG8_LDB(B1, 0, 1); PG8_SCHED; PG8_LDA(At, 0, 0); PG8_STAGEA(PG8_SA(1, 1), a1, 1);
            if (last && has_next) PG8_GOFF(nxt);
            PG8_WAIT_V(8); PG8_WAIT_L(0); PG8_BAR; PG8_MMA(0, 0, At, B0); PG8_MMA(0, 1, At, B1); PG8_BAR; PG8_SCHED;
            PG8_LDA(At, 0, 1); PG8_STAGEB(PG8_SB(0, 0), b2); PG8_STAGEB(PG8_SB(0, 1), b2 + hstepB); PG8_STAGEA(PG8_SA(0, 0), a2, 0);
            PG8_WAIT_V(8); PG8_WAIT_L(0); PG8_BAR; PG8_MMA(1, 0, At, B0); PG8_MMA(1, 1, At, B1); PG8_BAR; PG8_SCHED;
            PG8_LDB(B0, 1, 0); PG8_LDB(B1, 1, 1); PG8_SCHED; PG8_LDA(At, 1, 0); PG8_STAGEA(PG8_SA(0, 1), a2, 1);
            PG8_WAIT_V(8); PG8_WAIT_L(0); PG8_BAR; PG8_MMA(0, 0, At, B0); PG8_MMA(0, 1, At, B1); PG8_BAR; PG8_SCHED;
            PG8_LDA(At, 1, 1); PG8_STAGEB(PG8_SB(1, 0), b3); PG8_STAGEB(PG8_SB(1, 1), b3 + hstepB); PG8_STAGEA(PG8_SA(1, 0), a3, 0);
            PG8_WAIT_V(8); PG8_WAIT_L(0); PG8_BAR; PG8_MMA(1, 0, At, B0); PG8_MMA(1, 1, At, B1); PG8_BAR; PG8_SCHED;
        }
        if (wr == 0) PG8_BAR;
        { int fr2 = fr, fq2 = fq, wr2 = wr, wc2 = wc; asm volatile("" : "+v"(fr2), "+v"(fq2), "+s"(wr2), "+s"(wc2)); E(acc, cur, wr2, wc2, fr2, fq2); }
        if (!has_next) break;
#pragma unroll
        for (int a = 0; a < 2; ++a)
#pragma unroll
            for (int b = 0; b < 2; ++b)
#pragma unroll
                for (int m = 0; m < 4; ++m)
#pragma unroll
                    for (int n = 0; n < 2; ++n) acc[a][b][m][n] = (f32x4){0.f, 0.f, 0.f, 0.f};
        cur = nxt; cA = nA; cB = nB; ++ui;
        if (wr == 1) PG8_BAR;
    }
    PG8_WAIT_V(0);
    PG8_BAR;
#undef PG8_SA
#undef PG8_SB
#undef PG8_STAGEA
#undef PG8_STAGEB
#undef PG8_LDA
#undef PG8_LDB
#undef PG8_MMA
#undef PG8_WAIT_V
#undef PG8_WAIT_L
#undef PG8_BAR
#undef PG8_SCHED
#undef PG8_GOFF
}
}
using pg8::Unit;
using pg8::Dims;

template <int SITE, class Epi, class Sched, bool GATHER = false>
__device__ __forceinline__ void gemm_run(LAS unsigned char* lds, const Dims g, const Sched& S, const Epi& E) {
    if constexpr (((FAST_MASK) >> SITE) & 1) pg8::gemm_fast<Epi, Sched, GATHER>(lds, g, S, E);
    else pg8::gemm_simple<Epi, Sched, GATHER>(g, S, E);
}

struct Frame {
    LAS unsigned char* lds;
    volatile LAS unsigned* MISC;
    LAS int* TAB;
    unsigned* ctl;
    unsigned char* ws;
    int tid, lane, wave, vcu, G;
    float* out;
};
constexpr int NXCD = 8, WGM = 8;

struct SchedDense {
    const char* A; const char* Bt; int lda, ldb, nM, nN, nwg, G, c;
    __device__ __forceinline__ bool next(int i, Unit& u) const {
        const long L = (long)i * G + c; if (L >= nwg) return false;
        int wgid = (int)L; { const int q = nwg / NXCD, r = nwg % NXCD, xcd = wgid % NXCD, off = wgid / NXCD; wgid = (xcd < r ? xcd * (q + 1) : r * (q + 1) + (xcd - r) * q) + off; }
        const int nig = WGM * nN, gid = wgid / nig, fm = gid * WGM, gsz = (nM - fm) < WGM ? (nM - fm) : WGM;
        u.pm = fm + ((wgid % nig) % gsz); u.pn = (wgid % nig) / gsz; u.x0 = 0; u.x1 = 0;
        u.a = A + (size_t)u.pm * 256 * lda * 2; u.b = Bt + (size_t)u.pn * 256 * ldb * 2; return true;
    }
    __device__ __forceinline__ int row_of(const Unit&, int R) const { return R; }
};
struct SchedRet3 {
    const char* PQ; const char* KR; const char* VS; const char* KDT; size_t kdt_dir_stride; int G, vcu;
    __device__ __forceinline__ bool next(int i, Unit& u) const {
        const int L = i * G + vcu; if (L >= NQK + NIDX * 4) return false;
        if (L < NQK) { u.pm = L; u.x0 = 0; u.x1 = 0; u.pn = 0; u.a = PQ + ((size_t)L * PQ_E + 256) * 2; u.b = KR + (size_t)L * KR_E * 2; }
        else { const int j = L - NQK, idx = j >> 2, dir = (j >> 1) & 1, half = j & 1; u.pm = idx; u.x0 = 1; u.x1 = dir * 2 + half; u.pn = 0;
            u.a = VS + ((size_t)idx * VS_E + (size_t)half * 256 * 768) * 2; u.b = KDT + (size_t)dir * kdt_dir_stride + (size_t)idx * KR_E * 2; }
        return true;
    }
    __device__ __forceinline__ int row_of(const Unit&, int R) const { return R; }
};
struct SchedO {
    const char* PQ; const char* VS; int G, vcu;
    __device__ __forceinline__ bool next(int i, Unit& u) const {
        const int L = i * G + vcu; if (L >= NQK * 2) return false;
        const int idx = L >> 1, half = L & 1; u.pm = idx; u.pn = half; u.x0 = 0; u.x1 = 0;
        u.a = PQ + (size_t)idx * PQ_E * 2; u.b = VS + ((size_t)idx * VS_E + (size_t)half * 256 * 768) * 2; return true;
    }
    __device__ __forceinline__ int row_of(const Unit&, int R) const { return R; }
};
struct SchedPool {
    const char* P; const char* W; int G, vcu;
    __device__ __forceinline__ bool next(int i, Unit& u) const {
        const int L = i * G + vcu; if (L >= 64 * 8) return false;
        const int pm = L >> 3, g = (L >> 1) & 3, half = L & 1; u.pm = pm; u.pn = g * 512 + half * 256; u.x0 = 0; u.x1 = 0;
        u.a = P + ((size_t)pm * 256 * D + (size_t)g * 512) * 2; u.b = W + ((size_t)g * 512 + (size_t)half * 256) * 512 * 2; return true;
    }
    __device__ __forceinline__ int row_of(const Unit&, int R) const { return R; }
};
struct SchedMoE {
    const LAS int* TAB; const char* A; const char* W; const int* rowl; int NT  , lda_bytes_per_row, G, vcu, gather; size_t wstride  , wtile  ;
    __device__ __forceinline__ bool next(int i, Unit& u) const {
        const int L = i * G + vcu; const int total = TAB[65];
        if (L >= total * NT) return false;
        const int pg = L / NT, pn = L - pg * NT;
        const int lane = threadIdx.x & 63;
        const int t1 = TAB[lane + 1];
        const int e = __builtin_popcountll(__ballot(t1 <= pg));
        const int panel = pg - TAB[e];
        u.pm = pg * 256; u.pn = pn; u.x0 = e; u.x1 = panel * 256;
        u.a = gather ? A : A + (size_t)pg * 256 * lda_bytes_per_row;
        u.b = W + (size_t)e * wstride + (size_t)pn * wtile; return true;
    }
    __device__ __forceinline__ int row_of(const Unit& u, int R) const {
        const int s = u.x1 + R;
        if (u.x0 == NE) return s;
        return (s < TAB[66 + u.x0]) ? rowl[(size_t)u.x0 * CAP + s] : 0;
    }
    __device__ __forceinline__ const int* row_ptr(const Unit& u, int R) const { const int e = u.x0 < NE ? u.x0 : 0; return rowl + (size_t)e * CAP + (u.x1 + R); }
    __device__ __forceinline__ int row_fix(const Unit& u, int R, int loaded) const {
        const int s = u.x1 + R;
        if (u.x0 == NE) return s;
        return (s < TAB[66 + u.x0]) ? loaded : 0;
    }
};


struct SchedWin {
    const char* HBp; const char* W; int G, vcu;
    __device__ __forceinline__ bool next(int i, Unit& u) const {
        const int L = i * G + vcu; if (L >= 2064 + 1056) return false;
        if (L < 2064) {
            int pm, pn;
            if (L < 2048) { const int gid = L >> 8, r = L & 255, t32 = r >> 3; pm = gid * 8 + (r & 7); pn = t32 < 16 ? t32 : t32 + 16; }
            else { const int j = L - 2048; pm = 64 + (j >> 3); pn = 8 + (j & 7); }
            u.pm = pm; u.pn = pn; u.x0 = 0; u.x1 = 0;
            u.a = HBp + (size_t)pm * 256 * D * 2; u.b = W + (size_t)pn * 256 * D * 2;
        } else {
            const int j = L - 2064, pm = j >> 4, rt = j & 15;
            u.pm = pm; u.pn = rt; u.x0 = 1; u.x1 = 0;
            u.a = W + (size_t)(4096 + 256 * rt) * D * 2; u.b = HBp + (size_t)pm * 256 * D * 2;
        }
        return true;
    }
    __device__ __forceinline__ int row_of(const Unit&, int R) const { return R; }
};
struct EpiWin {
    static constexpr bool PERM = true;
    bf16 *Kr, *Kdtf, *Kdtb, *PQ, *VS, *Gs; const float *ropeR, *ropeC, *l2f, *l2b;
    __device__ __forceinline__ void operator()(const f32x4 (&acc)[2][2][4][2], const Unit& u, int wr, int wc, int fr, int fq) const {
        const int pm = u.pm, pn = u.pn;
        if (u.x0 == 1) {
            const int h = pn >> 1, half = pn & 1, idx = pm * 8 + h;
#pragma unroll
            for (int ai = 0; ai < 2; ++ai)
#pragma unroll
                for (int m = 0; m < 4; ++m) {
                    const int dv = half * 256 + 128 * ai + 64 * wr + 16 * m + fr;
#pragma unroll
                    for (int bj = 0; bj < 2; ++bj)
                        *(u32x4*)(VS + (size_t)idx * VS_E + (size_t)dv * 768 + 128 * bj + 32 * wc + 8 * fq) = pack8(acc[ai][bj][m][0], acc[ai][bj][m][1]);
                }
            return;
        }
        if (pn < 16) {
            const int h = pn & 7; const bool isK = pn >= 8; const int idx = pm * 8 + h;
            const bool lat = pm < 64; const int pos0 = (pm & 31) * 256;
            const float lf = l2f[h], lb = l2b[h];
            const int i0 = 16 * wc + 4 * fq;
            f32x4 cR[2][2], cC[4][2];
#pragma unroll
            for (int ai = 0; ai < 2; ++ai) { const float* tab = ropeR + (size_t)((pos0 >> 6) + 2 * ai + wr) * 128 + 2 * i0; cR[ai][0] = *(const f32x4*)(tab); cR[ai][1] = *(const f32x4*)(tab + 4); }
#pragma unroll
            for (int m = 0; m < 4; ++m) { const float* tab = ropeC + (size_t)(16 * m + fr) * 128 + 2 * i0; cC[m][0] = *(const f32x4*)(tab); cC[m][1] = *(const f32x4*)(tab + 4); }
#pragma unroll
            for (int ai = 0; ai < 2; ++ai)
#pragma unroll
                for (int m = 0; m < 4; ++m) {
                    const int p = 128 * ai + 64 * wr + 16 * m + fr;
                    const float d1 = isK ? __builtin_amdgcn_exp2f(lf * (float)(255 - p)) * 0.0625f : __builtin_amdgcn_exp2f(lf * (float)(p + 1));
                    const float d2 = isK ? __builtin_amdgcn_exp2f(lb * (float)p) * 0.0625f : __builtin_amdgcn_exp2f(lb * (float)(256 - p));
#pragma unroll
                    for (int bj = 0; bj < 2; ++bj) {
                        const int dk0 = 128 * bj + 32 * wc + 8 * fq;
                        f32x4 v0 = acc[ai][bj][m][0], v1 = acc[ai][bj][m][1];
                        if (lat) {
                            const f32x4 c0 = (bj == 0) ? cR[ai][0] : cC[m][0], c1 = (bj == 0) ? cR[ai][1] : cC[m][1];
                            f32x4 r0, r1;
                            r0[0] = v0[0] * c0[0] - v0[1] * c0[1]; r0[1] = v0[0] * c0[1] + v0[1] * c0[0];
                            r0[2] = v0[2] * c0[2] - v0[3] * c0[3]; r0[3] = v0[2] * c0[3] + v0[3] * c0[2];
                            r1[0] = v1[0] * c1[0] - v1[1] * c1[1]; r1[1] = v1[0] * c1[1] + v1[1] * c1[0];
                            r1[2] = v1[2] * c1[2] - v1[3] * c1[3]; r1[3] = v1[2] * c1[3] + v1[3] * c1[2];
                            v0 = r0; v1 = r1;
                        }
                        if (!isK) {
                            bf16* row = PQ + (size_t)idx * PQ_E + (size_t)p * 768 + dk0;
                            *(u32x4*)(row + 256) = pack8(v0 * d1, v1 * d1);
                            *(u32x4*)(row + 512) = pack8(v0 * d2, v1 * d2);
                        } else {
                            *(u32x4*)(Kr + (size_t)idx * KR_E + (size_t)p * 256 + dk0) = pack8(v0 * 0.0625f, v1 * 0.0625f);
                            bf16* tf = Kdtf + (size_t)idx * KR_E + (size_t)dk0 * 256 + p;
                            bf16* tb = Kdtb + (size_t)idx * KR_E + (size_t)dk0 * 256 + p;
#pragma unroll
                            for (int j = 0; j < 4; ++j) {
                                const unsigned pf = cvt_pk_bf16(v0[j] * d1, v1[j] * d1), pb = cvt_pk_bf16(v0[j] * d2, v1[j] * d2);
                                tf[(size_t)j * 256] = (bf16)(pf & 0xffffu); tf[(size_t)(4 + j) * 256] = (bf16)(pf >> 16);
                                tb[(size_t)j * 256] = (bf16)(pb & 0xffffu); tb[(size_t)(4 + j) * 256] = (bf16)(pb >> 16);
                            }
                        }
                    }
                }
        } else {
            const int gc0 = (pn - 32) * 256;
#pragma unroll
            for (int ai = 0; ai < 2; ++ai)
#pragma unroll
                for (int m = 0; m < 4; ++m) {
                    const int r = 256 * pm + 128 * ai + 64 * wr + 16 * m + fr;
#pragma unroll
                    for (int bj = 0; bj < 2; ++bj) {
                        const int c = gc0 + 128 * bj + 32 * wc + 8 * fq;
                        f32x4 v0 = acc[ai][bj][m][0], v1 = acc[ai][bj][m][1];
                        *(u32x4*)(Gs + (size_t)r * VD + c) = pack8(v0, v1);
                        asm volatile("" ::: "memory");
                    }
                }
        }
    }
};
struct EpiRet3 {
    static constexpr bool PERM = true;
    bf16 *PQ, *U; const float *l2f, *l2b;
    __device__ __forceinline__ void operator()(const f32x4 (&acc)[2][2][4][2], const Unit& u, int wr, int wc, int fr, int fq) const {
        const int idx = u.pm;
        if (u.x0 == 0) {
            const int h = idx & 7; const float lf = l2f[h], lb = l2b[h];
#pragma unroll
            for (int ai = 0; ai < 2; ++ai)
#pragma unroll
                for (int m = 0; m < 4; ++m) {
                    const int p = 128 * ai + 64 * wr + 16 * m + fr;
#pragma unroll
                    for (int bj = 0; bj < 2; ++bj) {
                        const int c0 = 128 * bj + 32 * wc + 8 * fq;
                        u32x4 w;
#pragma unroll
                        for (int n = 0; n < 2; ++n) {
                            f32x4 v = acc[ai][bj][m][n];
#pragma unroll
                            for (int j = 0; j < 4; ++j) { const int cc = c0 + 4 * n + j, d = p - cc;
                                v[j] *= __builtin_amdgcn_exp2f(d >= 0 ? -lf * (float)(cc + 1) : lb * (float)(-d) - lf * (float)(p + 1)); }
                            const unsigned q0 = cvt_pk_bf16(v[0], v[1]), q1 = cvt_pk_bf16(v[2], v[3]);
                            if (n == 0) { w.x = q0; w.y = q1; } else { w.z = q0; w.w = q1; }
                        }
                        *(u32x4*)(PQ + (size_t)idx * PQ_E + (size_t)p * 768 + c0) = w;
                        asm volatile("" ::: "memory");
                    }
                }
        } else {
            const int dir = u.x1 >> 1, half = u.x1 & 1;
            bf16* base = U + ((size_t)idx * 2 + dir) * U_E;
#pragma unroll
            for (int ai = 0; ai < 2; ++ai)
#pragma unroll
                for (int m = 0; m < 4; ++m) {
                    const int dv = half * 256 + 128 * ai + 64 * wr + 16 * m + fr;
#pragma unroll
                    for (int bj = 0; bj < 2; ++bj) {
                        const int c0 = 128 * bj + 32 * wc + 8 * fq;
                        *(u32x4*)(base + (size_t)dv * 256 + c0) = pack8(acc[ai][bj][m][0], acc[ai][bj][m][1]);
                        asm volatile("" ::: "memory");
                    }
                }
        }
    }
};
struct EpiO {
    static constexpr bool PERM = true;
    bf16* O;
    __device__ __forceinline__ void operator()(const f32x4 (&acc)[2][2][4][2], const Unit& u, int wr, int wc, int fr, int fq) const {
        const int pm = u.pm >> 3, h = u.pm & 7, cb = h * 512 + u.pn * 256;
#pragma unroll
        for (int ai = 0; ai < 2; ++ai)
#pragma unroll
            for (int m = 0; m < 4; ++m) {
                const int r = 256 * pm + 128 * ai + 64 * wr + 16 * m + fr;
#pragma unroll
                for (int bj = 0; bj < 2; ++bj)
                    *(u32x4*)(O + (size_t)r * VD + cb + 128 * bj + 32 * wc + 8 * fq) = pack8(acc[ai][bj][m][0], acc[ai][bj][m][1]);
            }
    }
};
struct EpiResid {
    static constexpr bool PERM = false;
    float* R1; const float* xa; const float* xb; int nsplit; const float* gate; const float* cscale; int has_scale;
    __device__ __forceinline__ void operator()(const f32x4 (&acc)[2][2][4][2], const Unit& u, int wr, int wc, int fr, int fq) const {
        const int cb = u.pn * (has_scale ? 1 : 256);
        const int r0 = 256 * u.pm;
        const int v = (r0 < NLAT) ? (r0 >> 13) : 2;
        const float* gr = gate + (size_t)v * MODW;
        f32x4 gv[2][2];
#pragma unroll
        for (int bj = 0; bj < 2; ++bj)
#pragma unroll
            for (int n = 0; n < 2; ++n) { const int c = cb + 128 * bj + 32 * wc + 16 * n + 4 * fq; gv[bj][n] = *(const f32x4*)(gr + c); if (has_scale) gv[bj][n] = gv[bj][n] * *(const f32x4*)(cscale + c); }
#pragma unroll
        for (int ai = 0; ai < 2; ++ai) {
            f32x4 xv[4][2][2];
#pragma unroll
            for (int m = 0; m < 4; ++m) {
                const int r = r0 + 128 * ai + 64 * wr + 16 * m + fr;
                const float* xr = (r < nsplit) ? xa + (size_t)r * D : xb + (size_t)(r - nsplit) * D;
#pragma unroll
                for (int bj = 0; bj < 2; ++bj)
#pragma unroll
                    for (int n = 0; n < 2; ++n) xv[m][bj][n] = *(const f32x4*)(xr + cb + 128 * bj + 32 * wc + 16 * n + 4 * fq);
            }
#pragma unroll
            for (int m = 0; m < 4; ++m) {
                const int r = r0 + 128 * ai + 64 * wr + 16 * m + fr;
#pragma unroll
                for (int bj = 0; bj < 2; ++bj)
#pragma unroll
                    for (int n = 0; n < 2; ++n) *(f32x4*)(R1 + (size_t)r * D + cb + 128 * bj + 32 * wc + 16 * n + 4 * fq) = xv[m][bj][n] * ALPHA + gv[bj][n] * acc[ai][bj][m][n];
            }
        }
    }
};
struct EpiMoe1 {
    static constexpr bool PERM = true;
    bf16* ACT;
    __device__ __forceinline__ void operator()(const f32x4 (&acc)[2][2][4][2], const Unit& u, int wr, int wc, int fr, int fq) const {
#pragma unroll
        for (int ai = 0; ai < 2; ++ai)
#pragma unroll
            for (int m = 0; m < 4; ++m) {
                const int r = u.pm + 128 * ai + 64 * wr + 16 * m + fr;
                f32x4 v0, v1;
#pragma unroll
                for (int j = 0; j < 4; ++j) { v0[j] = silu_f(acc[ai][0][m][0][j]) * acc[ai][1][m][0][j]; v1[j] = silu_f(acc[ai][0][m][1][j]) * acc[ai][1][m][1][j]; }
                *(u32x4*)(ACT + (size_t)r * ED + u.pn * 128 + 32 * wc + 8 * fq) = pack8(v0, v1);
            }
    }
};
constexpr float Y_SCALE = 64.0f;
struct EpiMoe2 {
    static constexpr bool PERM = true;
    unsigned char* Y;
    __device__ __forceinline__ void operator()(const f32x4 (&acc)[2][2][4][2], const Unit& u, int wr, int wc, int fr, int fq) const {
#pragma unroll
        for (int ai = 0; ai < 2; ++ai)
#pragma unroll
            for (int m = 0; m < 4; ++m) {
                const int p = 128 * ai + 64 * wr + 16 * m + fr;
#pragma unroll
                for (int bj = 0; bj < 2; ++bj) {
                    f32x4 v0 = acc[ai][bj][m][0], v1 = acc[ai][bj][m][1];
#pragma unroll
                    for (int j = 0; j < 4; ++j) { v0[j] = __builtin_amdgcn_fmed3f(v0[j], -448.0f, 448.0f); v1[j] = __builtin_amdgcn_fmed3f(v1[j], -448.0f, 448.0f); }
                    int w0 = 0, w1 = 0;
                    w0 = __builtin_amdgcn_cvt_pk_fp8_f32(v0[0], v0[1], w0, false); w0 = __builtin_amdgcn_cvt_pk_fp8_f32(v0[2], v0[3], w0, true);
                    w1 = __builtin_amdgcn_cvt_pk_fp8_f32(v1[0], v1[1], w1, false); w1 = __builtin_amdgcn_cvt_pk_fp8_f32(v1[2], v1[3], w1, true);
                    u32x2 w; w.x = (unsigned)w0; w.y = (unsigned)w1;
                    *(u32x2*)(Y + (size_t)(u.pm + p) * D + 256 * u.pn + 128 * bj + 32 * wc + 8 * fq) = w;
                }
            }
    }
};

struct ConvJob { const float* src; bf16* dst; int ldw, ldt; float scale; };
__device__ __forceinline__ void conv_load(const ConvJob& j, f32x4 (&v)[16], int lane) {
    const float* src = j.src + (size_t)(lane >> 4) * j.ldw + (lane & 15) * 4;
#pragma unroll
    for (int i = 0; i < 16; ++i) v[i] = *(const f32x4*)(src + (size_t)(4 * i) * j.ldw);
}
__device__ __forceinline__ void conv_store(const ConvJob& j, const f32x4 (&v)[16], LAS float* scr, int lane) {
#pragma unroll
    for (int i = 0; i < 16; ++i) { LAS float* s = scr + (4 * i + (lane >> 4)) * 65 + (lane & 15) * 4; s[0] = v[i][0]; s[1] = v[i][1]; s[2] = v[i][2]; s[3] = v[i][3]; }
    LDS_WAIT(); asm volatile("" ::: "memory");
    const int c = lane & 7;
#pragma unroll
    for (int q = 0; q < 8; ++q) {
        const int n = (lane >> 3) + 8 * q; const LAS float* s = scr + (8 * c) * 65 + n;
        const float sc_ = j.scale;
        u32x4 o; o.x = cvt_pk_bf16(s[0 * 65] * sc_, s[1 * 65] * sc_); o.y = cvt_pk_bf16(s[2 * 65] * sc_, s[3 * 65] * sc_); o.z = cvt_pk_bf16(s[4 * 65] * sc_, s[5 * 65] * sc_); o.w = cvt_pk_bf16(s[6 * 65] * sc_, s[7 * 65] * sc_);
        *(u32x4*)(j.dst + (size_t)n * j.ldt + 8 * c) = o;
    }
    LDS_WAIT(); asm volatile("" ::: "memory");
}
struct JobP0 {
    const float *win, *wout, *wpool; bf16 *WINd, *WOUTd, *WPOOLd;
    static constexpr int N = 32 * 192 + 64 * 32 + 4 * 64;
    __device__ __forceinline__ ConvJob operator()(int r) const {
        ConvJob j; j.scale = 1.0f;
        if (r < 32 * 192) { const int kb = r / 192, nb = r % 192; j.src = win + (size_t)kb * 64 * RIN + nb * 64; j.ldw = RIN; j.dst = WINd + (size_t)nb * 64 * D + kb * 64; j.ldt = D; return j; }
        r -= 32 * 192;
        if (r < 64 * 32) { const int kb = r / 32, nb = r % 32; j.src = wout + (size_t)kb * 64 * D + nb * 64; j.ldw = D; j.dst = WOUTd + (size_t)nb * 64 * VD + kb * 64; j.ldt = VD; return j; }
        r -= 64 * 32;
        { const int g = r >> 6, t = r & 63, kb = t >> 3, nb = t & 7; j.src = wpool + (size_t)g * 512 * 512 + (size_t)kb * 64 * 512 + nb * 64; j.ldw = 512; j.dst = WPOOLd + (size_t)g * 512 * 512 + (size_t)nb * 64 * 512 + kb * 64; j.ldt = 512; return j; }
    }
};
struct JobExp {
    const float *eg, *eu, *ed, *sg, *su, *sd; bf16 *W13, *W2; int layer, mode;
    __device__ __forceinline__ int count() const { return NE1 * (mode == 0 ? 512 : mode == 1 ? 256 : 768); }
    __device__ __forceinline__ ConvJob operator()(int it) const {
        const int per = (mode == 0 ? 512 : mode == 1 ? 256 : 768);
        const int e = it / per; int r = it - e * per; if (mode == 1) r += 512;
        const int mat = r >> 8, t = r & 255;
        ConvJob j; j.scale = (mat < 2) ? 1.0f : 64.0f;
        if (mat < 2) {
            const float* We = mat ? eu : eg; const float* Ws = mat ? su : sg;
            const float* W = (e < NE) ? We + ((size_t)layer * NE + e) * (size_t)(D * ED) : Ws + (size_t)layer * (D * ED);
            const int kb = t >> 3, n0 = (t & 7) * 64;
            j.src = W + (size_t)kb * 64 * ED + n0; j.ldw = ED;
            j.dst = W13 + (size_t)e * W13_E + (size_t)((n0 >> 7) * 256 + (n0 & 127) + mat * 128) * D + kb * 64; j.ldt = D;
        } else {
            const float* W = (e < NE) ? ed + ((size_t)layer * NE + e) * (size_t)(ED * D) : sd + (size_t)layer * (ED * D);
            const int kb = t >> 5, nb = t & 31;
            j.src = W + (size_t)kb * 64 * D + nb * 64; j.ldw = D;
            j.dst = W2 + (size_t)e * W2_E + (size_t)nb * 64 * ED + kb * 64; j.ldt = ED;
        }
        return j;
    }
};
struct JobTail {
    JobExp a, b; int from;
    __device__ __forceinline__ int count() const { return (a.count() - from) + b.count(); }
    __device__ __forceinline__ ConvJob operator()(int it) const { const int na = a.count() - from; return it < na ? a(from + it) : b(it - na); }
};
template <class Dec>
__device__ __forceinline__ void conv_loop(const Dec& dec, int first, int stride, int n, LAS float* scr, int lane) {
    for (int g = first; 3 * g < n; g += stride) {
        const int it = 3 * g;
        const bool h1 = it + 1 < n, h2 = it + 2 < n;
        const ConvJob j0 = dec(it); ConvJob j1 = j0, j2 = j0;
        f32x4 v0[16], v1[16], v2[16];
        conv_load(j0, v0, lane);
        if (h1) { j1 = dec(it + 1); conv_load(j1, v1, lane); }
        if (h2) { j2 = dec(it + 2); conv_load(j2, v2, lane); }
        conv_store(j0, v0, scr, lane);
        if (h1) conv_store(j1, v1, scr, lane);
        if (h2) conv_store(j2, v2, scr, lane);
    }
}
struct Roles { int is_conv, g_rank, g_count, c_rank, c_count; };
__device__ __forceinline__ Roles make_roles(const Frame& F, int nper) {
    Roles r; const int per = F.G / 8, bx = blockIdx.x, x = bx % 8, rix = bx / 8;
    if (F.G % 8 != 0 || nper <= 0 || nper >= per) { r.is_conv = 0; r.g_rank = F.vcu; r.g_count = F.G; r.c_rank = F.vcu; r.c_count = F.G; return r; }
    r.is_conv = rix >= per - nper; r.g_rank = x * (per - nper) + rix; r.g_count = 8 * (per - nper); r.c_rank = x * nper + (rix - (per - nper)); r.c_count = 8 * nper;
    return r;
}
__device__ __forceinline__ void sincos_d(double a, float& s, float& c) {
    const double TWO_PI = 6.283185307179586476925286766559;
    const double k = __builtin_rint(a / TWO_PI);
    const double r = a - k * TWO_PI;
    const double r2 = r * r;
    double ts = r, tc = 1.0, ss = r, cc = 1.0;
#pragma unroll
    for (int i = 1; i <= 14; ++i) { tc = -tc * r2 / (double)((2 * i - 1) * (2 * i)); ts = -ts * r2 / (double)((2 * i) * (2 * i + 1)); cc += tc; ss += ts; }
    s = (float)ss; c = (float)cc;
}

__device__ __forceinline__ void build_moe_tab(Frame& F, int layer, int ntok) {
    int tid_ = (int)threadIdx.x; asm volatile("" : "+v"(tid_));
    if (tid_ < 64) {
        const int cnt = (int)__hip_atomic_load(F.ctl + CW_CNT + (layer * 64 + tid_) * 64, RLX_AGENT);
        F.TAB[66 + tid_] = cnt;
        const int pn = (cnt + 255) >> 8;
        int incl = pn;
#pragma unroll
        for (int o = 1; o < 64; o <<= 1) { const int t = __shfl_up(incl, o); if ((tid_ & 63) >= o) incl += t; }
        F.TAB[tid_ + 1] = incl;
        if (tid_ == 0) F.TAB[0] = 0;
        if (tid_ == 63) F.TAB[65] = incl + ntok / 256;
    }
    LDS_WAIT();
    __syncthreads();
}

struct Args { const float* in[24]; float* out; unsigned char* ws; int ph_lo, ph_hi; };

#ifndef PH_MASK
#define PH_MASK 0x3ffff
#endif
#define IN(k) ((((PH_MASK) >> ((k) >= 14 ? (k) - 6 : (k))) & 1) && lo <= (k) && (k) < hi)
#define SEAM(k) do { if (IN(k) && IN((k) + 1)) xcd_barrier(bar); } while (0)

#define MOD ((float*)(ws + WS_MOD))
#define ROPER ((float*)(ws + WS_ROPE))
#define ROPEC (ROPER + 128 * 64 * 2)
#define L2F ((float*)(ws + WS_L2G))
#define L2B (L2F + 8)
#define RW ((bf16*)(ws + WS_RW))
#define TOKE ((int*)(ws + WS_TOKE))
#define TOKP ((int*)(ws + WS_TOKP))
#define ROWL ((int*)(ws + WS_ROWL))
#define SLOTG ((float*)(ws + WS_SLOTG))
#define WIN ((bf16*)(ws + WS_WIN))
#define WOUT ((bf16*)(ws + WS_WOUT))
#define WPOOL ((bf16*)(ws + WS_WPOOL))
#define HB ((bf16*)(ws + WS_HB))
#define XL ((float*)(ws + WS_XL))
#define R1 ((float*)(ws + WS_R1))
#define KR ((bf16*)(ws + WS_KR))
#define KDTF ((bf16*)(ws + WS_KDTF))
#define KDTB ((bf16*)(ws + WS_KDTB))
#define PQ ((bf16*)(ws + WS_PQ))
#define VS ((bf16*)(ws + WS_VS))
#define UB ((bf16*)(ws + WS_U))
#define GS ((bf16*)(ws + WS_GS))
#define OB ((bf16*)(ws + WS_O))
#define A2 ((bf16*)(ws + WS_A2))
#define ACT ((bf16*)(ws + WS_ACT))
#define YB ((unsigned char*)(ws + WS_Y))
template <int layer>
__device__ __forceinline__ void layer_tail(Frame& F, const Args& args, const int lo, const int hi, const XcdBarrier& bar) {
    unsigned char* const ws = args.ws;
    const int gw = F.vcu * NWAVES + F.wave, NGW = F.G * NWAVES;
    LAS float* scr = (LAS float*)(F.lds + F.wave * 16640);
        const int ntok = NLAT;
        const int pb = layer ? 14 : 8;
        const float* modL = MOD + (size_t)layer * 3 * MODW;
        bf16* W13 = (bf16*)(ws + (layer ? WS_W13_1 : WS_W13_0)); bf16* W2 = (bf16*)(ws + (layer ? WS_W2_1 : WS_W2_0));
        unsigned* cntw = F.ctl + CW_CNT + layer * 64 * 64;

        if (layer == 1) {
            if (IN(12)) {
                for (int it = gw; it < 256 * 8; it += NGW) {
                    const int grow = it >> 3, ch = it & 7, c = ch * 256 + F.lane * 4;
                    const int wdw = 2 << (c >> 9), hw = wdw >> 1;
                    const float* md = MOD + (size_t)(3 + (grow >> 7)) * MODW;
                    const f32x4 sh = *(const f32x4*)(md + c), sc = *(const f32x4*)(md + D + c) + 1.0f;
                    const float* xb = XL + (size_t)grow * 64 * D + c;
                    f32x4 sum = {0.f, 0.f, 0.f, 0.f};
                    for (int j = 0; j < hw; ++j) sum += *(const f32x4*)(xb + (size_t)j * D) * sc + sh;
#pragma unroll 4
                    for (int t = 0; t < 64; ++t) {
                        const int lo2 = (t - hw) < 0 ? 0 : (t - hw), hi2 = (t + hw) > 64 ? 64 : (t + hw);
                        const f32x4 self = *(const f32x4*)(xb + (size_t)t * D) * sc + sh;
                        const f32x4 p = sum * (1.0f / (float)(hi2 - lo2)) - self;
                        u32x2 w; w.x = cvt_pk_bf16(p[0], p[1]); w.y = cvt_pk_bf16(p[2], p[3]);
                        *(u32x2*)(HB + ((size_t)grow * 64 + t) * D + c) = w;
                        if (t + hw < 64) sum += *(const f32x4*)(xb + (size_t)(t + hw) * D) * sc + sh;
                        if (t - hw >= 0) sum -= *(const f32x4*)(xb + (size_t)(t - hw) * D) * sc + sh;
                    }
                }
            }
            SEAM(12);
            if (IN(13)) {
                SchedPool S{(const char*)HB, (const char*)WPOOL, F.G, F.vcu};
                EpiResid E{R1, XL, XL, NLAT, MOD + (size_t)3 * MODW + 2 * D, args.in[15], 1};
                gemm_run<4>(F.lds, Dims{D, 512, 512}, S, E);
            }
            SEAM(13);
        }

        if (IN(pb)) {
            const float* lng = args.in[6] + (size_t)layer * D; const float* lnb = args.in[7] + (size_t)layer * D;
            const bf16* rwh = RW + (size_t)(layer * 2) * NE * D; const bf16* rwl = rwh + (size_t)NE * D;
            const float* rbias = args.in[17] + layer * NE;
            LAS float* PART = (LAS float*)F.lds;
            bf16* HL = (bf16*)(ws + WS_Y);
            const int fr = F.lane & 15, fq = F.lane >> 4;
            const float rb = rbias[F.lane];
            LAS int* LCNT = F.TAB + 512; LAS int* LBASE = F.TAB + 576; LAS int* ASG = F.TAB + 640; LAS float* ASGG = (LAS float*)(F.TAB + 1152);
            const int nblocks = ntok / 16;
            for (int blk0 = F.vcu; blk0 < nblocks; blk0 += 4 * F.G) {
                int nst = 0;
#pragma unroll
                for (int q = 0; q < 4; ++q) nst += (blk0 + q * F.G < nblocks) ? 1 : 0;
                if (F.tid < 64) LCNT[F.tid] = 0;
                f32x4 xa[2][8];
#pragma unroll
                for (int rr = 0; rr < 2; ++rr)
#pragma unroll
                    for (int j = 0; j < 8; ++j) xa[rr][j] = *(const f32x4*)(R1 + (size_t)(blk0 * 16 + 2 * F.wave + rr) * D + j * 256 + F.lane * 4);
                for (int st = 0; st < nst; ++st) {
                    const int r0 = (blk0 + st * F.G) * 16;
                    const float* md = modL + (size_t)(r0 >> 13) * MODW;
                    float rs2[2];
#pragma unroll
                    for (int rr = 0; rr < 2; ++rr) {
                        float sm = 0.f;
#pragma unroll
                        for (int j = 0; j < 8; ++j) sm += (xa[rr][j][0] + xa[rr][j][1]) + (xa[rr][j][2] + xa[rr][j][3]);
                        const float mu = wave_sum(sm) * (1.0f / D); float sq = 0.f;
#pragma unroll
                        for (int j = 0; j < 8; ++j) { xa[rr][j] = xa[rr][j] - mu; sq += (xa[rr][j][0] * xa[rr][j][0] + xa[rr][j][1] * xa[rr][j][1]) + (xa[rr][j][2] * xa[rr][j][2] + xa[rr][j][3] * xa[rr][j][3]); }
                        rs2[rr] = 1.0f / sqrtf(wave_sum(sq) * (1.0f / D) + LN_EPS);
                    }
#pragma unroll
                    for (int rr = 0; rr < 2; ++rr) {
                        const size_t ro = (size_t)(r0 + 2 * F.wave + rr) * D;
#pragma unroll
                        for (int jh = 0; jh < 8; jh += 4) {
                            f32x4 vg[4], vb[4], vsc[4], vsh[4];
#pragma unroll
                            for (int j2 = 0; j2 < 4; ++j2) { const int c = (jh + j2) * 256 + F.lane * 4; vg[j2] = *(const f32x4*)(lng + c); vb[j2] = *(const f32x4*)(lnb + c); vsc[j2] = *(const f32x4*)(md + 4 * D + c); vsh[j2] = *(const f32x4*)(md + 3 * D + c); }
#pragma unroll
                            for (int j2 = 0; j2 < 4; ++j2) {
                                const int j = jh + j2, c = j * 256 + F.lane * 4;
                                const f32x4 y = xa[rr][j] * rs2[rr] * vg[j2] + vb[j2];
                                *(f32x4*)(XL + ro + c) = y;
                                const f32x4 hh = y * (vsc[j2] + 1.0f) + vsh[j2];
                                u32x2 wh, wl;
                                const unsigned b0 = f2bf(hh[0]), b1 = f2bf(hh[1]), b2 = f2bf(hh[2]), b3 = f2bf(hh[3]);
                                wh.x = b0 | (b1 << 16); wh.y = b2 | (b3 << 16);
                                wl.x = cvt_pk_bf16(hh[0] - bf2f(b0), hh[1] - bf2f(b1)); wl.y = cvt_pk_bf16(hh[2] - bf2f(b2), hh[3] - bf2f(b3));
                                *(u32x2*)(HB + ro + c) = wh;
                                *(u32x2*)(HL + ro + c) = wl;
                            }
                        }
                    }
                    {
                        const int nb = (st + 1 < nst) ? blk0 + (st + 1) * F.G : blk0 + st * F.G;
#pragma unroll
                        for (int rr = 0; rr < 2; ++rr)
#pragma unroll
                            for (int j = 0; j < 8; ++j) xa[rr][j] = *(const f32x4*)(R1 + (size_t)(nb * 16 + 2 * F.wave + rr) * D + j * 256 + F.lane * 4);
                    }
                }
                VM_WAIT(); LDS_WAIT(); __syncthreads();
                f32x4 lg[4][4];
#pragma unroll
                for (int st = 0; st < 4; ++st)
#pragma unroll
                    for (int j = 0; j < 4; ++j) lg[st][j] = (f32x4){0.f, 0.f, 0.f, 0.f};
#pragma unroll 2
                for (int ks = 0; ks < 8; ++ks) {
                    const int c = 256 * F.wave + ks * 32 + fq * 8;
                    bf16x8 bh[4], bl[4];
#pragma unroll
                    for (int j = 0; j < 4; ++j) { bh[j] = *(const bf16x8*)(rwh + (size_t)(16 * j + fr) * D + c); bl[j] = *(const bf16x8*)(rwl + (size_t)(16 * j + fr) * D + c); }
#pragma unroll
                    for (int st = 0; st < 4; ++st) {
                        const int bb = (st < nst) ? blk0 + st * F.G : blk0;
                        const size_t ao = (size_t)(bb * 16 + fr) * D + c;
                        const bf16x8 ah = *(const bf16x8*)(HB + ao), al = *(const bf16x8*)(HL + ao);
#pragma unroll
                        for (int j = 0; j < 4; ++j) {
                            lg[st][j] = __builtin_amdgcn_mfma_f32_16x16x32_bf16(ah, bh[j], lg[st][j], 0, 0, 0);
                            lg[st][j] = __builtin_amdgcn_mfma_f32_16x16x32_bf16(al, bh[j], lg[st][j], 0, 0, 0);
                            lg[st][j] = __builtin_amdgcn_mfma_f32_16x16x32_bf16(ah, bl[j], lg[st][j], 0, 0, 0);
                        }
                    }
                }
#pragma unroll
                for (int st = 0; st < 4; ++st)
#pragma unroll
                    for (int j = 0; j < 4; ++j)
#pragma unroll
                        for (int q = 0; q < 4; ++q) PART[F.wave * 4096 + (st * 16 + 4 * fq + q) * 64 + 16 * j + fr] = lg[st][j][q];
                LDS_WAIT(); __syncthreads();
                for (int tt = 0; tt < 8; ++tt) {
                    const int q = 8 * F.wave + tt;
                    if ((q >> 4) >= nst) break;
                    float logit = 0.f;
#pragma unroll
                    for (int w2 = 0; w2 < 8; ++w2) logit += PART[w2 * 4096 + q * 64 + F.lane];
                    const float score = 1.0f / (1.0f + __expf(-logit));
                    const float bsd = score + rb;
                    float m1 = bsd;
                    m1 = fmaxf(m1, __shfl_xor(m1, 1)); m1 = fmaxf(m1, __shfl_xor(m1, 2)); m1 = fmaxf(m1, __shfl_xor(m1, 4));
                    const unsigned long long eqm = __ballot(bsd == m1);
                    const unsigned seg = (unsigned)(eqm >> (F.lane & ~7)) & 0xffu;
                    const int first = __builtin_ctz(seg);
                    float m2 = ((F.lane & 7) == first) ? -__builtin_inff() : bsd;
                    m2 = fmaxf(m2, __shfl_xor(m2, 1)); m2 = fmaxf(m2, __shfl_xor(m2, 2)); m2 = fmaxf(m2, __shfl_xor(m2, 4));
                    const float gs = m1 + m2;
                    int grank = 0; const int myg = F.lane >> 3;
#pragma unroll
                    for (int g2 = 0; g2 < 8; ++g2) { const float o = __shfl(gs, g2 * 8); grank += (o > gs || (o == gs && g2 < myg)) ? 1 : 0; }
                    const float mv = (grank < 4) ? bsd : -__builtin_inff();
                    int rank = 0;
                    unsigned long long gbits = __ballot(grank < 4) & 0x0101010101010101ull;
#pragma unroll 1
                    for (int it = 0; it < 4; ++it) {
                        const int b0 = __builtin_amdgcn_readfirstlane((int)__builtin_ctzll(gbits)); gbits &= gbits - 1;
#pragma unroll
                        for (int j2 = 0; j2 < 8; ++j2) { const int e2 = b0 + j2; const float o = __builtin_bit_cast(float, __builtin_amdgcn_readlane(__builtin_bit_cast(int, mv), e2)); rank += (o > mv || (o == mv && e2 < F.lane)) ? 1 : 0; }
                    }
                    const bool sel = rank < 8;
                    const float ssum = wave_sum(sel ? score : 0.f);
                    if (sel) {
                        const float gate = score / ssum * ROUTED_SCALE;
                        const int local = __hip_atomic_fetch_add(LCNT + F.lane, 1, __ATOMIC_RELAXED, __HIP_MEMORY_SCOPE_WORKGROUP);
                        ASG[q * 8 + rank] = F.lane | (local << 8); ASGG[q * 8 + rank] = gate;
                    }
                }
                LDS_WAIT(); __syncthreads();
                if (F.tid < 64) { const int c = LCNT[F.tid]; LBASE[F.tid] = c ? (int)__hip_atomic_fetch_add(cntw + F.tid * 64, (unsigned)c, RLX_AGENT) : 0; }
                LDS_WAIT(); __syncthreads();
                if (F.tid < nst * 128) {
                    const int q = F.tid >> 3, rank = F.tid & 7, a = ASG[F.tid], e = a & 0xff, pos = LBASE[e] + (a >> 8);
                    const int t = (blk0 + (q >> 4) * F.G) * 16 + (q & 15);
                    ROWL[(size_t)e * CAP + pos] = t; SLOTG[(size_t)t * 8 + rank] = ASGG[F.tid];
                    TOKE[(size_t)t * 8 + rank] = e; TOKP[(size_t)t * 8 + rank] = pos;
                }
                LDS_WAIT(); __syncthreads();
            }
            if (layer == 0 && (CONV_P9 == 0 || CONV_P10 == 0 || F.G % 8 != 0 || CONV_P9 >= F.G / 8)) {
                __syncthreads();
                JobExp dec{args.in[18], args.in[19], args.in[20], args.in[21], args.in[22], args.in[23], (bf16*)(ws + WS_W13_1), (bf16*)(ws + WS_W2_1), 1, 2};
                conv_loop(dec, gw, NGW, dec.count(), scr, F.lane);
            }
        }
        SEAM(pb);

        if (IN(pb + 1)) {
            build_moe_tab(F, layer, ntok);
            const Roles R = make_roles(F, (layer == 0 && CONV_P10 > 0) ? CONV_P9 : 0);
            if (!R.is_conv) {
                SchedMoE S{F.TAB, (const char*)HB, (const char*)W13, ROWL, 4, D * 2, R.g_count, R.g_rank, 1, W13_E * 2, (size_t)256 * D * 2};
                EpiMoe1 E{ACT};
                gemm_run<5, EpiMoe1, SchedMoE, true>(F.lds, Dims{D, D, D}, S, E);
            } else {
                JobExp dec{args.in[18], args.in[19], args.in[20], args.in[21], args.in[22], args.in[23], (bf16*)(ws + WS_W13_1), (bf16*)(ws + WS_W2_1), 1, 0};
                conv_loop(dec, R.c_rank * NWAVES + F.wave, R.c_count * NWAVES, W13_SPLIT < dec.count() ? W13_SPLIT : dec.count(), scr, F.lane);
            }
            __syncthreads();
        }
        SEAM(pb + 1);

        if (IN(pb + 2)) {
            build_moe_tab(F, layer, ntok);
            const Roles R = make_roles(F, (layer == 0 && CONV_P9 > 0) ? CONV_P10 : 0);
            if (!R.is_conv) {
                SchedMoE S{F.TAB, (const char*)ACT, (const char*)W2, ROWL, 8, ED * 2, R.g_count, R.g_rank, 0, W2_E * 2, (size_t)256 * ED * 2};
                EpiMoe2 E{YB};
                gemm_run<6>(F.lds, Dims{ED, ED, ED}, S, E);
            } else {
                JobExp d0{args.in[18], args.in[19], args.in[20], args.in[21], args.in[22], args.in[23], (bf16*)(ws + WS_W13_1), (bf16*)(ws + WS_W2_1), 1, 0};
                JobExp d1{args.in[18], args.in[19], args.in[20], args.in[21], args.in[22], args.in[23], (bf16*)(ws + WS_W13_1), (bf16*)(ws + WS_W2_1), 1, 1};
                JobTail dec{d0, d1, W13_SPLIT < d0.count() ? W13_SPLIT : d0.count()};
                conv_loop(dec, R.c_rank * NWAVES + F.wave, R.c_count * NWAVES, dec.count(), scr, F.lane);
            }
            __syncthreads();
        }
        SEAM(pb + 2);

        if (IN(pb + 3)) {
            build_moe_tab(F, layer, ntok);
            const float* lng = args.in[8] + (size_t)layer * D; const float* lnb = args.in[9] + (size_t)layer * D;
            float* dst = layer ? F.out : XL;
            int eN[8], pN[8]; float gN[8], gC[8];
            u32x2 yv[4][9]; f32x4 xr_[8];
            {
                const int t = (gw < ntok) ? gw : 0, t1 = (t + NGW < ntok) ? t + NGW : t;
                int slot[9];
#pragma unroll
                for (int k = 0; k < 8; ++k) slot[k] = F.TAB[TOKE[(size_t)t * 8 + k]] * 256 + TOKP[(size_t)t * 8 + k];
                slot[8] = F.TAB[64] * 256 + t;
#pragma unroll
                for (int j = 0; j < 4; ++j) {
                    const int c = j * 512 + F.lane * 8;
#pragma unroll
                    for (int k = 0; k < 9; ++k) yv[j][k] = *(const u32x2*)(YB + (size_t)slot[k] * D + c);
                    xr_[2 * j] = *(const f32x4*)(XL + (size_t)t * D + c); xr_[2 * j + 1] = *(const f32x4*)(XL + (size_t)t * D + c + 4);
                }
#pragma unroll
                for (int k = 0; k < 8; ++k) { eN[k] = TOKE[(size_t)t1 * 8 + k]; pN[k] = TOKP[(size_t)t1 * 8 + k]; gN[k] = SLOTG[(size_t)t1 * 8 + k]; gC[k] = SLOTG[(size_t)t * 8 + k]; }
            }
            for (int t = gw; t < ntok; t += NGW) {
                const int v = (t < NLAT) ? (t >> 13) : 2;
                const float* g2 = modL + (size_t)v * MODW + 5 * D;
                f32x4 x[8]; float sm = 0.f;
#pragma unroll
                for (int j = 0; j < 4; ++j) {
                    const int c = j * 512 + F.lane * 8;
                    f32x4 f0 = {0.f, 0.f, 0.f, 0.f}, f1 = {0.f, 0.f, 0.f, 0.f};
#pragma unroll
                    for (int k = 0; k < 9; ++k) {
                        const u32x2 y2 = yv[j][k];
                        const float g = (k < 8) ? gC[k < 8 ? k : 0] : 1.0f;
                        f0[0] += g * __builtin_amdgcn_cvt_f32_fp8((int)y2.x, 0); f0[1] += g * __builtin_amdgcn_cvt_f32_fp8((int)y2.x, 1); f0[2] += g * __builtin_amdgcn_cvt_f32_fp8((int)y2.x, 2); f0[3] += g * __builtin_amdgcn_cvt_f32_fp8((int)y2.x, 3);
                        f1[0] += g * __builtin_amdgcn_cvt_f32_fp8((int)y2.y, 0); f1[1] += g * __builtin_amdgcn_cvt_f32_fp8((int)y2.y, 1); f1[2] += g * __builtin_amdgcn_cvt_f32_fp8((int)y2.y, 2); f1[3] += g * __builtin_amdgcn_cvt_f32_fp8((int)y2.y, 3);
                    }
                    x[2 * j] = xr_[2 * j] * ALPHA + *(const f32x4*)(g2 + c) * (f0 * (1.0f / Y_SCALE));
                    x[2 * j + 1] = xr_[2 * j + 1] * ALPHA + *(const f32x4*)(g2 + c + 4) * (f1 * (1.0f / Y_SCALE));
                    sm += (x[2 * j][0] + x[2 * j][1]) + (x[2 * j][2] + x[2 * j][3]) + (x[2 * j + 1][0] + x[2 * j + 1][1]) + (x[2 * j + 1][2] + x[2 * j + 1][3]);
                }
                const int tn = (t + NGW < ntok) ? t + NGW : t, tnn = (tn + NGW < ntok) ? tn + NGW : tn;
                {
                    int slot[9];
#pragma unroll
                    for (int k = 0; k < 8; ++k) slot[k] = F.TAB[eN[k]] * 256 + pN[k];
                    slot[8] = F.TAB[64] * 256 + tn;
#pragma unroll
                    for (int j = 0; j < 4; ++j) {
                        const int c = j * 512 + F.lane * 8;
#pragma unroll
                        for (int k = 0; k < 9; ++k) yv[j][k] = *(const u32x2*)(YB + (size_t)slot[k] * D + c);
                        xr_[2 * j] = *(const f32x4*)(XL + (size_t)tn * D + c); xr_[2 * j + 1] = *(const f32x4*)(XL + (size_t)tn * D + c + 4);
                    }
#pragma unroll
                    for (int k = 0; k < 8; ++k) { gC[k] = gN[k]; eN[k] = TOKE[(size_t)tnn * 8 + k]; pN[k] = TOKP[(size_t)tnn * 8 + k]; gN[k] = SLOTG[(size_t)tnn * 8 + k]; }
                }
                const float mu = wave_sum(sm) * (1.0f / D); float sq = 0.f;
#pragma unroll
                for (int j = 0; j < 8; ++j) { x[j] = x[j] - mu; sq += (x[j][0] * x[j][0] + x[j][1] * x[j][1]) + (x[j][2] * x[j][2] + x[j][3] * x[j][3]); }
                const float rstd = 1.0f / sqrtf(wave_sum(sq) * (1.0f / D) + LN_EPS);
#pragma unroll
                for (int j = 0; j < 4; ++j) {
                    const int c = j * 512 + F.lane * 8;
                    *(f32x4*)(dst + (size_t)t * D + c) = x[2 * j] * rstd * *(const f32x4*)(lng + c) + *(const f32x4*)(lnb + c);
                    *(f32x4*)(dst + (size_t)t * D + c + 4) = x[2 * j + 1] * rstd * *(const f32x4*)(lng + c + 4) + *(const f32x4*)(lnb + c + 4);
                }
            }
            __syncthreads();
        }
        SEAM(pb + 3);
    }

__global__ void __launch_bounds__(NWAVES * 64, 2) mk_fwd(Args args) {
    extern __shared__ __attribute__((aligned(16))) unsigned char lds_raw[];
    Frame F;
    F.lds = (LAS unsigned char*)lds_raw;
    F.TAB = (LAS int*)(F.lds + LDSCTL_OFF);
    F.MISC = (volatile LAS unsigned*)(F.lds + LDSCTL_OFF + 1024);
    F.tid = threadIdx.x; F.lane = F.tid & 63; F.wave = __builtin_amdgcn_readfirstlane(F.tid >> 6);
    F.G = gridDim.x; { const int bx = blockIdx.x; F.vcu = (F.G % 8 == 0) ? (bx % 8) * (F.G / 8) + bx / 8 : bx; }
    F.ws = args.ws; F.ctl = (unsigned*)(args.ws + WS_CTL); F.out = args.out;
    for (int u = F.tid; u < (LDS_BYTES - LDSCTL_OFF) / 4; u += NWAVES * 64) ((LAS unsigned*)(F.lds + LDSCTL_OFF))[u] = 0u;
    __syncthreads();
    const int lo = args.ph_lo, hi = args.ph_hi;
    XcdBarrier bar; bar.bar = (unsigned*)(F.ctl + CW_BAR); bar.x = 0; bar.st = nullptr;
    if (hi - lo > 1) bar = xcd_barrier_post((unsigned*)(F.ctl + CW_BAR) + (size_t)lo * XCD_BAR_WORDS, F.MISC + 8);
    unsigned char* const ws = args.ws;
    const int gw = F.vcu * NWAVES + F.wave, NGW = F.G * NWAVES;
    LAS float* scr = (LAS float*)(F.lds + F.wave * 16640);

    if (IN(0)) {
        for (int it = F.vcu; it < 2 * 96; it += F.G) {
            const int l = it / 96, c0 = (it % 96) * 128 + 2 * F.lane;
            const float* W = args.in[4] + (size_t)l * D * MODW + c0;
            f32x2 a0 = {0.f, 0.f}, a1 = {0.f, 0.f}, a2 = {0.f, 0.f};
            for (int kc = 256 * F.wave; kc < 256 * F.wave + 256; kc += 64) {
                const float s0 = silu_f(args.in[1][kc + F.lane]), s1 = silu_f(args.in[1][D + kc + F.lane]), s2 = silu_f(args.in[3][kc + F.lane]);
#pragma unroll 16
                for (int kk = 0; kk < 64; ++kk) {
                    const f32x2 w = *(const f32x2*)(W + (size_t)(kc + kk) * MODW);
                    const float b0 = __builtin_bit_cast(float, __builtin_amdgcn_readlane(__builtin_bit_cast(int, s0), kk)), b1 = __builtin_bit_cast(float, __builtin_amdgcn_readlane(__builtin_bit_cast(int, s1), kk)), b2 = __builtin_bit_cast(float, __builtin_amdgcn_readlane(__builtin_bit_cast(int, s2), kk));
                    a0 += w * b0; a1 += w * b1; a2 += w * b2;
                }
            }
            LAS f32x2* red = (LAS f32x2*)F.lds;
            red[(F.wave * 3 + 0) * 64 + F.lane] = a0; red[(F.wave * 3 + 1) * 64 + F.lane] = a1; red[(F.wave * 3 + 2) * 64 + F.lane] = a2;
            LDS_WAIT(); __syncthreads();
            if (F.wave < 3) {
                f32x2 t = {0.f, 0.f};
#pragma unroll
                for (int w2 = 0; w2 < 8; ++w2) t += red[(w2 * 3 + F.wave) * 64 + F.lane];
                const f32x2 bb = *(const f32x2*)(args.in[5] + (size_t)l * MODW + c0);
                *(f32x2*)(MOD + ((size_t)l * 3 + F.wave) * MODW + c0) = t + bb;
            }
            LDS_WAIT(); __syncthreads();
        }
        const int gt = F.vcu * 512 + F.tid, NGT = F.G * 512;
        for (int i = gt; i < 192 * 64; i += NGT) {
            const int j = i & 63, rc = i >> 6;
            double fr = 1.0; for (int q = 0; q < j; ++q) fr *= 0.8659643233600653;
            const double ang = (double)(rc < 128 ? rc : rc - 128) * fr;
            float s, c; sincos_d(ang, s, c);
            float* dst = (rc < 128) ? ROPER + ((size_t)rc * 64 + j) * 2 : ROPEC + ((size_t)(rc - 128) * 64 + j) * 2;
            dst[0] = c; dst[1] = s;
        }
        if (gt < 16) { const float raw = (gt < 8) ? args.in[12][gt] : args.in[13][gt - 8];
            const float v = -log1pf(expf(-raw)) * 1.44269504088896341f; if (gt < 8) L2F[gt] = v; else L2B[gt - 8] = v; }
        for (int i = gt; i < 2 * D * NE; i += NGT) {
            const int l = i / (D * NE), r = i % (D * NE), k = r / NE, e = r % NE;
            const float w = args.in[16][i]; const unsigned whi = f2bf(w); const float wlo = w - bf2f(whi);
            RW[((size_t)(l * 2 + 0) * NE + e) * D + k] = (bf16)whi; RW[((size_t)(l * 2 + 1) * NE + e) * D + k] = (bf16)f2bf(wlo);
        }
        { JobP0 dec{args.in[10], args.in[11], args.in[14], WIN, WOUT, WPOOL}; conv_loop(dec, gw, NGW, JobP0::N, scr, F.lane); }
        if (CONV_P2 == 0 || F.G % 8 != 0 || CONV_P2 >= F.G / 8) { JobExp dec{args.in[18], args.in[19], args.in[20], args.in[21], args.in[22], args.in[23], (bf16*)(ws + WS_W13_0), (bf16*)(ws + WS_W2_0), 0, 2}; conv_loop(dec, gw, NGW, dec.count(), scr, F.lane); }
    }
    SEAM(0);

    if (IN(1)) {
        for (int r = gw; r < NTOK0; r += NGW) {
            const float* xr = (r < NLAT) ? args.in[0] + (size_t)r * D : args.in[2] + (size_t)(r - NLAT) * D;
            const int v = (r < NLAT) ? (r >> 13) : 2;
            const float* md = MOD + (size_t)v * MODW;
#pragma unroll
            for (int j = 0; j < 4; ++j) {
                const int c = j * 512 + F.lane * 8;
                const f32x4 x0 = *(const f32x4*)(xr + c), x1 = *(const f32x4*)(xr + c + 4);
                const f32x4 h0 = *(const f32x4*)(md + c), h1 = *(const f32x4*)(md + c + 4), s0 = *(const f32x4*)(md + D + c), s1 = *(const f32x4*)(md + D + c + 4);
                *(u32x4*)(HB + (size_t)r * D + c) = pack8(x0 * (s0 + 1.0f) + h0, x1 * (s1 + 1.0f) + h1);
            }
        }
    }
    SEAM(1);

    if (IN(2)) {
        const Roles R = make_roles(F, CONV_P2);
        if (!R.is_conv) {
            SchedWin S{(const char*)HB, (const char*)WIN, R.g_count, R.g_rank};
            EpiWin E{KR, KDTF, KDTB, PQ, VS, GS, ROPER, ROPEC, L2F, L2B};
            gemm_run<0>(F.lds, Dims{D, D, D}, S, E);
        } else {
            JobExp dec{args.in[18], args.in[19], args.in[20], args.in[21], args.in[22], args.in[23], (bf16*)(ws + WS_W13_0), (bf16*)(ws + WS_W2_0), 0, 2};
            conv_loop(dec, R.c_rank * NWAVES + F.wave, R.c_count * NWAVES, dec.count(), scr, F.lane);
        }
    }
    SEAM(2);

    if (IN(3)) {
        SchedRet3 S{(const char*)PQ, (const char*)KR, (const char*)VS, (const char*)KDTF, (size_t)(WS_KDTB - WS_KDTF), F.G, F.vcu};
        EpiRet3 E{PQ, UB, L2F, L2B};
        gemm_run<1>(F.lds, Dims{768, 256, 256}, S, E);
    }
    SEAM(3);

    if (IN(4)) {
        const int gt = F.vcu * 512 + F.tid, NGT = F.G * 512;
        for (int it = gt; it < 16 * 2 * 512 * 32; it += NGT) {
            const int dkc = it & 31, dv = (it >> 5) & 511, dir = (it >> 14) & 1, bh = it >> 15, b = bh >> 3, h = bh & 7;
            const float dec = exp2f((dir ? L2B[h] : L2F[h]) * 256.0f);
            float s[8];
#pragma unroll
            for (int j = 0; j < 8; ++j) s[j] = 0.f;
            for (int st = 0; st < 33; ++st) {
                const int pm = (st == 0) ? 64 + b : b * 32 + (dir ? 32 - st : st - 1);
                const size_t idx = (size_t)pm * 8 + h;
                u32x4 w; w.x = cvt_pk_bf16(s[0], s[1]); w.y = cvt_pk_bf16(s[2], s[3]); w.z = cvt_pk_bf16(s[4], s[5]); w.w = cvt_pk_bf16(s[6], s[7]);
                *(u32x4*)(VS + idx * VS_E + (size_t)dv * 768 + 256 + dir * 256 + dkc * 8) = w;
                const u32x4 uv = *(const u32x4*)(UB + (idx * 2 + dir) * U_E + (size_t)dv * 256 + dkc * 8);
                s[0] = s[0] * dec + bf2f(uv.x & 0xffffu); s[1] = s[1] * dec + bf2f(uv.x >> 16);
                s[2] = s[2] * dec + bf2f(uv.y & 0xffffu); s[3] = s[3] * dec + bf2f(uv.y >> 16);
                s[4] = s[4] * dec + bf2f(uv.z & 0xffffu); s[5] = s[5] * dec + bf2f(uv.z >> 16);
                s[6] = s[6] * dec + bf2f(uv.w & 0xffffu); s[7] = s[7] * dec + bf2f(uv.w >> 16);
            }
        }
    }
    SEAM(4);

    if (IN(5)) {
        SchedO S{(const char*)PQ, (const char*)VS, F.G, F.vcu};
        EpiO E{OB};
        gemm_run<2>(F.lds, Dims{768, 768, 768}, S, E);
    }
    SEAM(5);

    if (IN(6)) {
        for (int it0 = gw; it0 < NLAT * NH; it0 += 4 * NGW) {
            u32x4 ov[4], gv[4]; size_t off[4];
#pragma unroll
            for (int q = 0; q < 4; ++q) { const int it = it0 + q * NGW;
                const int itc = it < NLAT * NH ? it : it0;
                off[q] = (size_t)(itc >> 3) * VD + (size_t)(itc & 7) * 512 + F.lane * 8;
                ov[q] = *(const u32x4*)(OB + off[q]); gv[q] = *(const u32x4*)(GS + off[q]); }
            u32x4 wq[4];
#pragma unroll
            for (int q = 0; q < 4; ++q) {
                float o[8], g[8];
                o[0] = bf2f(ov[q].x & 0xffffu); o[1] = bf2f(ov[q].x >> 16); o[2] = bf2f(ov[q].y & 0xffffu); o[3] = bf2f(ov[q].y >> 16);
                o[4] = bf2f(ov[q].z & 0xffffu); o[5] = bf2f(ov[q].z >> 16); o[6] = bf2f(ov[q].w & 0xffffu); o[7] = bf2f(ov[q].w >> 16);
                g[0] = bf2f(gv[q].x & 0xffffu); g[1] = bf2f(gv[q].x >> 16); g[2] = bf2f(gv[q].y & 0xffffu); g[3] = bf2f(gv[q].y >> 16);
                g[4] = bf2f(gv[q].z & 0xffffu); g[5] = bf2f(gv[q].z >> 16); g[6] = bf2f(gv[q].w & 0xffffu); g[7] = bf2f(gv[q].w >> 16);
#pragma unroll
                for (int j = 0; j < 8; ++j) g[j] = silu_f(g[j]);
                float sm = 0.f;
#pragma unroll
                for (int j = 0; j < 8; ++j) sm += o[j];
                const float mu = wave_sum(sm) * (1.0f / 512.0f);
                float sq = 0.f;
#pragma unroll
                for (int j = 0; j < 8; ++j) { o[j] -= mu; sq += o[j] * o[j]; }
                const float rstd = 1.0f / sqrtf(wave_sum(sq) * (1.0f / 512.0f) + LN_EPS);
                wq[q].x = cvt_pk_bf16(o[0] * rstd * g[0], o[1] * rstd * g[1]); wq[q].y = cvt_pk_bf16(o[2] * rstd * g[2], o[3] * rstd * g[3]);
                wq[q].z = cvt_pk_bf16(o[4] * rstd * g[4], o[5] * rstd * g[5]); wq[q].w = cvt_pk_bf16(o[6] * rstd * g[6], o[7] * rstd * g[7]);
            }
#pragma unroll
            for (int q = 0; q < 4; ++q) if (it0 + q * NGW < NLAT * NH) *(u32x4*)(A2 + off[q]) = wq[q];
        }
    }
    SEAM(6);

    if (IN(7)) {
        SchedDense S{(const char*)A2, (const char*)WOUT, VD, VD, 64, D / 256, 64 * (D / 256), F.G, (int)blockIdx.x};
        EpiResid E{R1, args.in[0], args.in[2], NLAT, MOD + 2 * D, nullptr, 0};
        gemm_run<3>(F.lds, Dims{VD, VD, VD}, S, E);
    }
    SEAM(7);

    layer_tail<0>(F, args, lo, hi, bar);
    layer_tail<1>(F, args, lo, hi, bar);
}

extern "C" void kernel_launch(void* const* d_in, const int* in_sizes, int n_in, void* d_out, int out_size, void* d_ws, size_t ws_size, hipStream_t stream) {
    static int grid = 0;
    if (grid == 0) {
        if (n_in != 24 || in_sizes[0] != NLAT * D || out_size != NLAT * D || ws_size < WS_END) {
            fprintf(stderr, "kernel_launch: unexpected problem (n_in %d, in0 %d, out %d, ws %zu; need ws >= %zu); nothing launched\n", n_in, n_in > 0 ? in_sizes[0] : -1, out_size, ws_size, (size_t)WS_END);
            grid = -1; return; }
        int dev = 0, cus = 0, per_cu = 0;
        if (hipGetDevice(&dev) != hipSuccess || hipDeviceGetAttribute(&cus, hipDeviceAttributeMultiprocessorCount, dev) != hipSuccess) { grid = -1; return; }
        if (hipFuncSetAttribute((const void*)mk_fwd, hipFuncAttributeMaxDynamicSharedMemorySize, LDS_BYTES) != hipSuccess) { fprintf(stderr, "kernel_launch: hipFuncSetAttribute failed\n"); grid = -1; return; }
        if (hipOccupancyMaxActiveBlocksPerMultiprocessor(&per_cu, (const void*)mk_fwd, NWAVES * 64, LDS_BYTES) != hipSuccess || per_cu < 1) {
            fprintf(stderr, "kernel_launch: occupancy query reports %d workgroups per CU\n", per_cu); }
        (void)hipGetLastError();
        grid = cus;
    }
    if (grid < 0) return;
    if (hipMemsetAsync((char*)d_ws + WS_CTL, 0, CTL_ZERO_BYTES, stream) != hipSuccess) { fprintf(stderr, "kernel_launch: memset failed\n"); return; }
    Args a{};
    for (int i = 0; i < 24; ++i) a.in[i] = (const float*)d_in[i];
    a.out = (float*)d_out; a.ws = (unsigned char*)d_ws;
#if MK_PER_PHASE
    for (int p = 0; p < PH_LIMIT; ++p) { a.ph_lo = p; a.ph_hi = p + 1; hipLaunchKernelGGL(mk_fwd, dim3(grid), dim3(NWAVES * 64), LDS_BYTES, stream, a); }
#else
    a.ph_lo = 0; a.ph_hi = NPH; hipLaunchKernelGGL(mk_fwd, dim3(grid), dim3(NWAVES * 64), LDS_BYTES, stream, a);
#endif
    const hipError_t le = hipPeekAtLastError();
    if (le != hipSuccess) fprintf(stderr, "kernel_launch: launch failed: %s\n", hipGetErrorName(le));
}
```

```cpp
#include <hip/hip_runtime.h>
#include <cstdio>
#include <cstdint>

#define GAS __attribute__((address_space(1)))
#define LAS __attribute__((address_space(3)))
typedef unsigned short bf16;
typedef short bf16x8 __attribute__((ext_vector_type(8)));
typedef float f32x4 __attribute__((ext_vector_type(4)));
typedef float f32x2 __attribute__((ext_vector_type(2)));
typedef unsigned u32x4 __attribute__((ext_vector_type(4)));
typedef unsigned u32x2 __attribute__((ext_vector_type(2)));

#ifndef MK_PER_PHASE
#define MK_PER_PHASE 0
#endif
#ifndef FAST_MASK
#define FAST_MASK 0x7f
#endif
#ifndef CONV_P2
#define CONV_P2 6
#endif
#ifndef CONV_P9
#define CONV_P9 4
#endif
#ifndef CONV_P10
#define CONV_P10 6
#endif
#ifndef W13_SPLIT
#define W13_SPLIT 24000
#endif
#ifndef PH_LIMIT
#define PH_LIMIT 18
#endif

constexpr int D = 2048, NB = 2, SEQ = 8192, NLAT = NB * SEQ, CTXL = 256, NCTX = NB * CTXL, NTOK0 = NLAT + NCTX;
constexpr int NH = 8, DKH = 256, DVH = 512, VD = 4096, RIN = 12288;
constexpr int NE = 64, NE1 = 65, ED = 512;
constexpr int MODW = 6 * D;
constexpr float ALPHA = 1.41421356237309515f, LN_EPS = 1e-5f, ROUTED_SCALE = 2.5f;
constexpr int CAP = 16896;
constexpr int NPANEL0 = NTOK0 / 256;
constexpr int NIDX = NPANEL0 * NH;
constexpr int NQK = 64 * NH;
constexpr int NPH = 18;

constexpr size_t MiB = 1u << 20;
constexpr size_t WS_CTL = 0, CTL_ZERO_BYTES = 1 * MiB;
constexpr size_t WS_MOD = 1 * MiB;
constexpr size_t WS_ROPE = 1 * MiB + 512 * 1024;
constexpr size_t WS_L2G = WS_ROPE + 128 * 1024;
constexpr size_t WS_RW = 2 * MiB;
constexpr size_t WS_TOKE = 4 * MiB, WS_TOKP = 5 * MiB;
constexpr size_t WS_ROWL = 6 * MiB, WS_SLOTG = 11 * MiB;
constexpr size_t WS_WIN = 16 * MiB, WS_WOUT = 64 * MiB, WS_WPOOL = 80 * MiB;
constexpr size_t WS_W13_0 = 82 * MiB, WS_W2_0 = 342 * MiB;
constexpr size_t WS_HB = 472 * MiB, WS_XL = 538 * MiB, WS_R1 = 670 * MiB, WS_S = 802 * MiB;
constexpr size_t WS_KR = WS_S, WS_KDTF = WS_S + 66 * MiB, WS_KDTB = WS_S + 132 * MiB, WS_PQ = WS_S + 198 * MiB, WS_VS = WS_S + 396 * MiB;
constexpr size_t WS_U = WS_S + 792 * MiB, WS_GS = WS_S + 1056 * MiB, WS_O = WS_U, WS_A2 = WS_S;
constexpr size_t WS_W13_1 = WS_S, WS_W2_1 = WS_S + 260 * MiB, WS_ACT = WS_S + 390 * MiB, WS_Y = WS_S + 556 * MiB;
constexpr size_t WS_END = 2048 * MiB;
static_assert(WS_GS + 132 * MiB <= WS_END && WS_Y + 658 * MiB <= WS_END && WS_ACT + 166 * MiB <= WS_Y, "ws map");
constexpr size_t PQ_E = 256 * 768, VS_E = 512 * 768, KR_E = 256 * 256, U_E = 512 * 256;
constexpr size_t W13_E = 1024 * 2048, W2_E = 2048 * 512;
constexpr int CW_CNT = 8192;
constexpr int CW_BAR = 4096;

constexpr int RING_BYTES = 131072;
constexpr int SCR_BYTES = 8 * 16640;
constexpr int LDSCTL_OFF = 136 * 1024;
constexpr int LDS_BYTES = 147456;
static_assert(SCR_BYTES <= LDSCTL_OFF, "lds");
constexpr int NWAVES = 8;

#define RLX_AGENT __ATOMIC_RELAXED, __HIP_MEMORY_SCOPE_AGENT
#define LDS_WAIT() asm volatile("s_waitcnt lgkmcnt(0)" ::: "memory")
#define VM_WAIT() asm volatile("s_waitcnt vmcnt(0)" ::: "memory")

__device__ __forceinline__ unsigned cvt_pk_bf16(float lo, float hi) { unsigned r; asm volatile("v_cvt_pk_bf16_f32 %0, %1, %2" : "=v"(r) : "v"(lo), "v"(hi)); return r; }
__device__ __forceinline__ unsigned f2bf(float f) { unsigned u = __builtin_bit_cast(unsigned, f); return (u + 0x7fffu + ((u >> 16) & 1u)) >> 16; }
__device__ __forceinline__ float bf2f(unsigned b) { return __builtin_bit_cast(float, b << 16); }
__device__ __forceinline__ u32x4 pack8(f32x4 a, f32x4 b) { u32x4 w; w.x = cvt_pk_bf16(a[0], a[1]); w.y = cvt_pk_bf16(a[2], a[3]); w.z = cvt_pk_bf16(b[0], b[1]); w.w = cvt_pk_bf16(b[2], b[3]); return w; }
__device__ __forceinline__ float silu_f(float x) { return x * __builtin_amdgcn_rcpf(1.0f + __expf(-x)); }
__device__ __forceinline__ float wave_sum(float v) {
#pragma unroll
    for (int o = 1; o < 64; o <<= 1) v += __shfl_xor(v, o);
    return v;
}
__device__ __forceinline__ float wave_max(float v) {
#pragma unroll
    for (int o = 1; o < 64; o <<= 1) v = fmaxf(v, __shfl_xor(v, o));
    return v;
}

#define XB_TMO      128
#define XB_XCNT(j)  (256  + 64 * (j))
#define XB_XSUB(j)  (1280 + 64 * (j))
#define XB_XGEN(j)  (2304 + 64 * (j))
#define XB_TOP      3328
#define XB_TOPGEN   3392
#define XCD_BAR_WORDS 3456
#define XB_SPIN_CAP (1u << 18)
__device__ __forceinline__ unsigned xb_ld(unsigned* p)              { return __hip_atomic_load(p, __ATOMIC_RELAXED, __HIP_MEMORY_SCOPE_AGENT); }
__device__ __forceinline__ unsigned xb_add(unsigned* p, unsigned v) { return __hip_atomic_fetch_add(p, v, __ATOMIC_RELAXED, __HIP_MEMORY_SCOPE_AGENT); }
__device__ __forceinline__ unsigned xb_xcc_id() { return (unsigned)__builtin_amdgcn_s_getreg((3 << 11) | 20) & 0xFu; }
#define XB_SPIN(cond, bar) do { unsigned _sp = 0; while (cond) { __builtin_amdgcn_s_sleep(1); \
    if ((++_sp & 255u) == 0u) { if (xb_ld(&(bar)[XB_TMO])) break; if (_sp > XB_SPIN_CAP) { atomicAdd(&(bar)[XB_TMO], 1u); break; } } } } while (0)
struct XcdBarrier { unsigned* bar; unsigned x; volatile LAS unsigned* st; };
__device__ __forceinline__ XcdBarrier xcd_barrier_post(unsigned* bar, volatile LAS unsigned* st) {
    XcdBarrier b; b.bar = bar; b.x = xb_xcc_id(); b.st = st;
    if (threadIdx.x == 0) (void)xb_add(&bar[XB_XCNT(b.x)], 1u);
    return b;
}
__device__ __forceinline__ void xcd_barrier_complete(unsigned* bar, unsigned x, unsigned& nloc, unsigned& nx) {
    const unsigned G = gridDim.x * gridDim.y * gridDim.z;
    unsigned sum, cnt, mine, sp = 0u;
    for (;;) {
        sum = 0u; cnt = 0u; mine = 0u;
#pragma unroll
        for (unsigned j = 0; j < 16; ++j) { const unsigned c = xb_ld(&bar[XB_XCNT(j)]); sum += c; cnt += (c > 0u) ? 1u : 0u; mine = (j == x) ? c : mine; }
        if (sum == G) break;
        __builtin_amdgcn_s_sleep(1);
        if ((++sp & 255u) == 0u) { if (xb_ld(&bar[XB_TMO])) break; if (sp > XB_SPIN_CAP) { atomicAdd(&bar[XB_TMO], 1u); break; } }
    }
    nloc = mine > 0u ? mine : 1u; nx = cnt > 0u ? cnt : 1u;
}
__device__ __forceinline__ void xcd_barrier(const XcdBarrier& b) {
    asm volatile("s_waitcnt vmcnt(0)" ::: "memory");
    __syncthreads();
    if (threadIdx.x == 0) {
        unsigned* bar = b.bar;
        __builtin_amdgcn_s_waitcnt(0);
        unsigned nloc = b.st[0], nx = b.st[1];
        if (nloc == 0u) { xcd_barrier_complete(bar, b.x, nloc, nx); b.st[0] = nloc; b.st[1] = nx; }
        const unsigned old = xb_add(&bar[XB_XSUB(b.x)], 1u);
        const unsigned gen = old / nloc;
        if (old + 1u == (gen + 1u) * nloc) {
            __builtin_amdgcn_fence(__ATOMIC_RELEASE, "agent");
            asm volatile("s_waitcnt vmcnt(0)" ::: "memory");
            const unsigned og = xb_add(&bar[XB_TOP], 1u);
            const unsigned tg = og / nx;
            if (og + 1u == (tg + 1u) * nx) xb_add(&bar[XB_TOPGEN], 1u);
            else XB_SPIN(xb_ld(&bar[XB_TOPGEN]) == tg, bar);
            __builtin_amdgcn_fence(__ATOMIC_ACQUIRE, "agent");
            xb_add(&bar[XB_XGEN(b.x)], 1u);
            asm volatile("s_waitcnt vmcnt(0)" ::: "memory");
        } else {
            XB_SPIN(xb_ld(&bar[XB_XGEN(b.x)]) == gen, bar);
            __builtin_amdgcn_fence(__ATOMIC_ACQUIRE, "agent");
            asm volatile("s_waitcnt vmcnt(0)" ::: "memory");
        }
    }
    __syncthreads();
}

namespace pg8 {
constexpr int BM = 256, BK = 64, HALF = 128, HTB = HALF * BK * 2, STAGE_BYTES = 8 * HTB;
__host__ __device__ __forceinline__ int lds_byte(int r, int c) { const int st = (r >> 4) * 2 + (c >> 5), rr = r & 15, cc = c & 31, ob = rr * 64 + cc * 2; return st * 1024 + (ob ^ (((ob >> 9) & 1) << 5)); }
__host__ __device__ __forceinline__ void stage_rc(int b, int& R, int& C) { const int st = b / 1024, sb = b % 1024, swz = sb ^ (((sb >> 9) & 1) << 5); R = (st >> 1) * 16 + swz / 64; C = (st & 1) * 32 + (swz % 64) / 2; }
__host__ __device__ __forceinline__ int perm32(int rho) { const int n = rho >> 4, i = rho & 15; return 8 * (i >> 2) + 4 * n + (i & 3); }

struct Unit { const char* a; const char* b; int pm, pn, x0, x1; };
struct Dims { int lda, ldb, K; };

template <class Epi, class Sched, bool GATHER>
__device__ __forceinline__ void gemm_simple(const Dims g, const Sched& S, const Epi& E) {
    const int tid = threadIdx.x, wid = __builtin_amdgcn_readfirstlane(tid >> 6), lane = tid & 63, wr = wid >> 2, wc = wid & 3, fr = lane & 15, fq = lane >> 4;
    Unit u;
    for (int ui = 0; S.next(ui, u); ++ui) {
        f32x4 acc[2][2][4][2];
#pragma unroll
        for (int a = 0; a < 2; ++a)
#pragma unroll
            for (int b = 0; b < 2; ++b)
#pragma unroll
                for (int m = 0; m < 4; ++m)
#pragma unroll
                    for (int n = 0; n < 2; ++n) acc[a][b][m][n] = (f32x4){0.f, 0.f, 0.f, 0.f};
        unsigned aoff[2][4], boff[2][2];
#pragma unroll
        for (int ai = 0; ai < 2; ++ai)
#pragma unroll
            for (int m = 0; m < 4; ++m) { const int R = 128 * ai + 64 * wr + 16 * m + fr; const int row = GATHER ? S.row_of(u, R) : R; aoff[ai][m] = ((unsigned)row * (unsigned)g.lda + (unsigned)fq * 8u) * 2u; }
#pragma unroll
        for (int bj = 0; bj < 2; ++bj)
#pragma unroll
            for (int n = 0; n < 2; ++n) { const int R = 128 * bj + 32 * wc + (Epi::PERM ? perm32(16 * n + fr) : 16 * n + fr); boff[bj][n] = ((unsigned)R * (unsigned)g.ldb + (unsigned)fq * 8u) * 2u; }
        for (int k = 0; k < g.K; k += 32) {
#pragma unroll
            for (int ai = 0; ai < 2; ++ai) {
                bf16x8 At[4];
#pragma unroll
                for (int m = 0; m < 4; ++m) At[m] = *(const bf16x8*)(u.a + aoff[ai][m] + (size_t)k * 2);
#pragma unroll
                for (int bj = 0; bj < 2; ++bj) {
                    bf16x8 Bt[2];
#pragma unroll
                    for (int n = 0; n < 2; ++n) Bt[n] = *(const bf16x8*)(u.b + boff[bj][n] + (size_t)k * 2);
#pragma unroll
                    for (int m = 0; m < 4; ++m)
#pragma unroll
                        for (int n = 0; n < 2; ++n) acc[ai][bj][m][n] = __builtin_amdgcn_mfma_f32_16x16x32_bf16(Bt[n], At[m], acc[ai][bj][m][n], 0, 0, 0);
                    asm volatile("" ::: "memory");
                }
            }
        }
        __syncthreads();
        { int fr2 = fr, fq2 = fq, wr2 = wr, wc2 = wc; asm volatile("" : "+v"(fr2), "+v"(fq2), "+s"(wr2), "+s"(wc2)); E(acc, u, wr2, wc2, fr2, fq2); }
    }
}

template <class Epi, class Sched, bool GATHER>
__device__ __forceinline__ void gemm_fast(LAS unsigned char* lds, const Dims g, const Sched& S, const Epi& E) {
    const int tid = threadIdx.x, wid = __builtin_amdgcn_readfirstlane(tid >> 6), lane = tid & 63, wr = wid >> 2, wc = wid & 3, fr = lane & 15, fq = lane >> 4;
    const int nt = g.K / BK;
    unsigned voffA[2][2], voffB[2];
#pragma unroll
    for (int i = 0; i < 2; ++i) { int R, C; stage_rc(tid * 16 + i * 8192, R, C); const int Rb = Epi::PERM ? ((R & ~31) + perm32(R & 31)) : R;
        voffA[0][i] = (unsigned)(R * g.lda + C) * 2u; voffA[1][i] = (unsigned)((R + HALF) * g.lda + C) * 2u; voffB[i] = (unsigned)(Rb * g.ldb + C) * 2u; }
    const size_t kstep = (size_t)(BK * 2);
    const size_t hstepB = (size_t)HALF * g.ldb * 2;
    const unsigned ldsw = (unsigned)wid * 1024u;
    const int aoff = lds_byte(wr * 64 + fr, fq * 8), boff = lds_byte(wc * 32 + fr, fq * 8);
#define PG8_SA(b, h) (((b) * 2 + (h)) * HTB)
#define PG8_SB(b, h) ((4 + (b) * 2 + (h)) * HTB)
#define PG8_STAGEA(bufoff, gbase, h) do { _Pragma("unroll") for (int _i = 0; _i < 2; ++_i) \
        __builtin_amdgcn_global_load_lds((const unsigned*)((const char*)(gbase) + voffA[h][_i]), (LAS unsigned*)(lds + (bufoff) + ldsw + _i * 8192), 16, 0, 0); } while (0)
#define PG8_STAGEB(bufoff, gbase) do { _Pragma("unroll") for (int _i = 0; _i < 2; ++_i) \
        __builtin_amdgcn_global_load_lds((const unsigned*)((const char*)(gbase) + voffB[_i]), (LAS unsigned*)(lds + (bufoff) + ldsw + _i * 8192), 16, 0, 0); } while (0)
#define PG8_LDA(dst, b, h) do { _Pragma("unroll") for (int m = 0; m < 4; ++m) _Pragma("unroll") for (int k = 0; k < 2; ++k) dst[m][k] = *(const LAS bf16x8*)(lds + PG8_SA(b, h) + aoff + m * 2048 + k * 1024); } while (0)
#define PG8_LDB(dst, b, h) do { _Pragma("unroll") for (int n = 0; n < 2; ++n) _Pragma("unroll") for (int k = 0; k < 2; ++k) dst[n][k] = *(const LAS bf16x8*)(lds + PG8_SB(b, h) + boff + n * 2048 + k * 1024); } while (0)
#define PG8_MMA(ai, bj, At, Bt) do { __builtin_amdgcn_s_setprio(1); _Pragma("unroll") for (int m = 0; m < 4; ++m) _Pragma("unroll") for (int n = 0; n < 2; ++n) _Pragma("unroll") for (int k = 0; k < 2; ++k) \
        acc[ai][bj][m][n] = __builtin_amdgcn_mfma_f32_16x16x32_bf16(Bt[n][k], At[m][k], acc[ai][bj][m][n], 0, 0, 0); __builtin_amdgcn_s_setprio(0); } while (0)
#define PG8_WAIT_V(n) asm volatile("s_waitcnt vmcnt(" #n ")" ::: "memory")
#define PG8_WAIT_L(n) asm volatile("s_waitcnt lgkmcnt(" #n ")" ::: "memory")
#define PG8_BAR __builtin_amdgcn_s_barrier()
#define PG8_SCHED __builtin_amdgcn_sched_barrier(0)
#define PG8_GOFF(uu) do { if constexpr (GATHER) { _Pragma("unroll") for (int _i = 0; _i < 2; ++_i) { int _R, _C; stage_rc((int)threadIdx.x * 16 + _i * 8192, _R, _C); _Pragma("unroll") for (int _h = 0; _h < 2; ++_h) \
        voffA[_h][_i] = ((unsigned)S.row_of(uu, _R + _h * HALF) * (unsigned)g.lda + (unsigned)_C) * 2u; } } } while (0)
    Unit cur, nxt; int ui = 0;
    if (!S.next(0, cur)) return;
    f32x4 acc[2][2][4][2];
#pragma unroll
    for (int a = 0; a < 2; ++a)
#pragma unroll
        for (int b = 0; b < 2; ++b)
#pragma unroll
            for (int m = 0; m < 4; ++m)
#pragma unroll
                for (int n = 0; n < 2; ++n) acc[a][b][m][n] = (f32x4){0.f, 0.f, 0.f, 0.f};
    bf16x8 At[4][2], B0[2][2], B1[2][2];
    const char* cA = cur.a; const char* cB = cur.b;
    PG8_GOFF(cur);
    PG8_STAGEB(PG8_SB(0, 0), cB); PG8_STAGEB(PG8_SB(0, 1), cB + hstepB); PG8_STAGEA(PG8_SA(0, 0), cA, 0); PG8_STAGEA(PG8_SA(0, 1), cA, 1);
    if (wr == 1) PG8_BAR;
    PG8_WAIT_V(2); PG8_BAR;
    PG8_STAGEB(PG8_SB(1, 0), cB + kstep); PG8_STAGEA(PG8_SA(1, 0), cA + kstep, 0); PG8_STAGEB(PG8_SB(1, 1), cB + hstepB + kstep);
    PG8_WAIT_V(6); PG8_BAR;
    for (;;) {
        const bool has_next = S.next(ui + 1, nxt);
        const char* nA = has_next ? nxt.a : cA; const char* nB = has_next ? nxt.b : cB;
        for (int t = 0; t < nt; t += 2) {
            const bool last = (t == nt - 2);
            const char* a1 = cA + (size_t)(t + 1) * kstep;
            const char* a2 = last ? nA : cA + (size_t)(t + 2) * kstep; const char* b2 = last ? nB : cB + (size_t)(t + 2) * kstep;
            const char* a3 = a2 + kstep; const char* b3 = b2 + kstep;
            PG8_LDB(B0, 0, 0); PG8_LDB(B1, 0, 1); PG8_SCHED; PG8_LDA(At, 0, 0); PG8_STAGEA(PG8_SA(1, 1), a1, 1);
            if (last && has_next) PG8_GOFF(nxt);
            PG8_WAIT_V(8); PG8_WAIT_L(0); PG8_BAR; PG8_MMA(0, 0, At, B0); PG8_MMA(0, 1, At, B1); PG8_BAR; PG8_SCHED;
            PG8_LDA(At, 0, 1); PG8_STAGEB(PG8_SB(0, 0), b2); PG8_STAGEB(PG8_SB(0, 1), b2 + hstepB); PG8_STAGEA(PG8_SA(0, 0), a2, 0);
            PG8_WAIT_V(8); PG8_WAIT_L(0); PG8_BAR; PG8_MMA(1, 0, At, B0); PG8_MMA(1, 1, At, B1); PG8_BAR; PG8_SCHED;
            PG8_LDB(B0, 1, 0); PG8_LDB(B1, 1, 1); PG8_SCHED; PG8_LDA(At, 1, 0); PG8_STAGEA(PG8_SA(0, 1), a2, 1);
            PG8_WAIT_V(8); PG8_WAIT_L(0); PG8_BAR; PG8_MMA(0, 0, At, B0); PG8_MMA(0, 1, At, B1); PG8_BAR; PG8_SCHED;
            PG8_LDA(At, 1, 1); PG8_STAGEB(PG8_SB(1, 0), b3); PG8_STAGEB(PG8_SB(1, 1), b3 + hstepB); PG8_STAGEA(PG8_SA(1, 0), a3, 0);
            PG8_WAIT_V(8); PG8_WAIT_L(0); PG8_BAR; PG8_MMA(1, 0, At, B0); PG8_MMA(1, 1, At, B1); PG8_BAR; PG8_SCHED;
        }
        if (wr == 0) PG8_BAR;
        { int fr2 = fr, fq2 = fq, wr2 = wr, wc2 = wc; asm volatile("" : "+v"(fr2), "+v"(fq2), "+s"(wr2), "+s"(wc2)); E(acc, cur, wr2, wc2, fr2, fq2); }
        if (!has_next) break;
#pragma unroll
        for (int a = 0; a < 2; ++a)
#pragma unroll
            for (int b = 0; b < 2; ++b)
#pragma unroll
                for (int m = 0; m < 4; ++m)
#pragma unroll
                    for (int n = 0; n < 2; ++n) acc[a][b][m][n] = (f32x4){0.f, 0.f, 0.f, 0.f};
        cur = nxt; cA = nA; cB = nB; ++ui;
        if (wr == 1) PG8_BAR;
    }
    PG8_WAIT_V(0);
    PG8_BAR;
#undef PG8_SA
#undef PG8_SB
#undef PG8_STAGEA
#undef PG8_STAGEB
#undef PG8_LDA
#undef PG8_LDB
#undef PG8_MMA
#undef PG8_WAIT_V
#undef PG8_WAIT_L
#undef PG8_BAR
#undef PG8_SCHED
#undef PG8_GOFF
}
}
using pg8::Unit;
using pg8::Dims;

template <int SITE, class Epi, class Sched, bool GATHER = false>
__device__ __forceinline__ void gemm_run(LAS unsigned char* lds, const Dims g, const Sched& S, const Epi& E) {
    if constexpr (((FAST_MASK) >> SITE) & 1) pg8::gemm_fast<Epi, Sched, GATHER>(lds, g, S, E);
    else pg8::gemm_simple<Epi, Sched, GATHER>(g, S, E);
}

struct Frame {
    LAS unsigned char* lds;
    volatile LAS unsigned* MISC;
    LAS int* TAB;
    unsigned* ctl;
    unsigned char* ws;
    int tid, lane, wave, vcu, G;
    float* out;
};
constexpr int NXCD = 8, WGM = 8;

struct SchedDense {
    const char* A; const char* Bt; int lda, ldb, nM, nN, nwg, G, c;
    __device__ __forceinline__ bool next(int i, Unit& u) const {
        const long L = (long)i * G + c; if (L >= nwg) return false;
        int wgid = (int)L; { const int q = nwg / NXCD, r = nwg % NXCD, xcd = wgid % NXCD, off = wgid / NXCD; wgid = (xcd < r ? xcd * (q + 1) : r * (q + 1) + (xcd - r) * q) + off; }
        const int nig = WGM * nN, gid = wgid / nig, fm = gid * WGM, gsz = (nM - fm) < WGM ? (nM - fm) : WGM;
        u.pm = fm + ((wgid % nig) % gsz); u.pn = (wgid % nig) / gsz; u.x0 = 0; u.x1 = 0;
        u.a = A + (size_t)u.pm * 256 * lda * 2; u.b = Bt + (size_t)u.pn * 256 * ldb * 2; return true;
    }
    __device__ __forceinline__ int row_of(const Unit&, int R) const { return R; }
};
struct SchedRet3 {
    const char* PQ; const char* KR; const char* VS; const char* KDT; size_t kdt_dir_stride; int G, vcu;
    __device__ __forceinline__ bool next(int i, Unit& u) const {
        const int L = i * G + vcu; if (L >= NQK + 2048) return false;
        if (L < NQK) { u.pm = L; u.x0 = 0; u.x1 = 0; u.pn = 0; u.a = PQ + ((size_t)L * PQ_E + 256) * 2; u.b = KR + (size_t)L * KR_E * 2; }
        else { const int j = L - NQK; int panel, h, dir; const int half = j & 1;
            if (j < 1984) { const int pq = j >> 5; h = (j >> 2) & 7; dir = (j >> 1) & 1; panel = pq < 60 ? (pq >= 30 ? 3 : 1) + pq : 4 + pq; }
            else { const int k = j - 1984, w = k >> 4; h = (k >> 1) & 7; dir = w & 1; panel = (w >> 1) * 32 + (w & 1) * 31; }
            const int idx = panel * 8 + h; u.pm = idx; u.x0 = 1; u.x1 = dir * 2 + half; u.pn = 0;
            u.a = VS + ((size_t)idx * VS_E + (size_t)half * 256 * 768) * 2; u.b = KDT + (size_t)dir * kdt_dir_stride + (size_t)idx * KR_E * 2; }
        return true;
    }
    __device__ __forceinline__ int row_of(const Unit&, int R) const { return R; }
};
struct SchedO {
    const char* PQ; const char* VS; int G, vcu;
    __device__ __forceinline__ bool next(int i, Unit& u) const {
        const int L = i * G + vcu; if (L >= NQK * 2) return false;
        const int idx = L >> 1, half = L & 1; u.pm = idx; u.pn = half; u.x0 = 0; u.x1 = 0;
        u.a = PQ + (size_t)idx * PQ_E * 2; u.b = VS + ((size_t)idx * VS_E + (size_t)half * 256 * 768) * 2; return true;
    }
    __device__ __forceinline__ int row_of(const Unit&, int R) const { return R; }
};
struct SchedPool {
    const char* P; const char* W; int G, vcu;
    __device__ __forceinline__ bool next(int i, Unit& u) const {
        const int L = i * G + vcu; if (L >= 64 * 8) return false;
        const int pm = L >> 3, g = (L >> 1) & 3, half = L & 1; u.pm = pm; u.pn = g * 512 + half * 256; u.x0 = 0; u.x1 = 0;
        u.a = P + ((size_t)pm * 256 * D + (size_t)g * 512) * 2; u.b = W + ((size_t)g * 512 + (size_t)half * 256) * 512 * 2; return true;
    }
    __device__ __forceinline__ int row_of(const Unit&, int R) const { return R; }
};
struct SchedMoE {
    const LAS int* TAB; const char* A; const char* W; const int* rowl; int NT  , lda_bytes_per_row, G, vcu, gather; size_t wstride  , wtile  ;
    __device__ __forceinline__ bool next(int i, Unit& u) const {
        const int L = i * G + vcu; const int total = TAB[65];
        if (L >= total * NT) return false;
        const int pg = L / NT, pn = L - pg * NT;
        const int lane = threadIdx.x & 63;
        const int t1 = TAB[lane + 1];
        const int e = __builtin_popcountll(__ballot(t1 <= pg));
        const int panel = pg - TAB[e];
        u.pm = pg * 256; u.pn = pn; u.x0 = e; u.x1 = panel * 256;
        u.a = gather ? A : A + (size_t)pg * 256 * lda_bytes_per_row;
        u.b = W + (size_t)e * wstride + (size_t)pn * wtile; return true;
    }
    __device__ __forceinline__ int row_of(const Unit& u, int R) const {
        const int s = u.x1 + R;
        if (u.x0 == NE) return s;
        return (s < TAB[66 + u.x0]) ? rowl[(size_t)u.x0 * CAP + s] : 0;
    }
    __device__ __forceinline__ const int* row_ptr(const Unit& u, int R) const { const int e = u.x0 < NE ? u.x0 : 0; return rowl + (size_t)e * CAP + (u.x1 + R); }
    __device__ __forceinline__ int row_fix(const Unit& u, int R, int loaded) const {
        const int s = u.x1 + R;
        if (u.x0 == NE) return s;
        return (s < TAB[66 + u.x0]) ? loaded : 0;
    }
};


struct SchedWin {
    const char* HBp; const char* W; int G, vcu;
    __device__ __forceinline__ bool next(int i, Unit& u) const {
        const int L = i * G + vcu; if (L >= 2064 + 1056) return false;
        if (L < 2064) {
            int pm, pn;
            if (L < 2048) { const int gid = L >> 8, r = L & 255, t32 = r >> 3; pm = gid * 8 + (r & 7); pn = t32 < 16 ? t32 : t32 + 16; }
            else { const int j = L - 2048; pm = 64 + (j >> 3); pn = 8 + (j & 7); }
            u.pm = pm; u.pn = pn; u.x0 = 0; u.x1 = 0;
            u.a = HBp + (size_t)pm * 256 * D * 2; u.b = W + (size_t)pn * 256 * D * 2;
        } else {
            const int j = L - 2064, pm = j >> 4, rt = j & 15;
            u.pm = pm; u.pn = rt; u.x0 = 1; u.x1 = 0;
            u.a = W + (size_t)(4096 + 256 * rt) * D * 2; u.b = HBp + (size_t)pm * 256 * D * 2;
        }
        return true;
    }
    __device__ __forceinline__ int row_of(const Unit&, int R) const { return R; }
};
struct EpiWin {
    static constexpr bool PERM = true;
    bf16 *Kr, *Kdtf, *Kdtb, *PQ, *VS, *Gs; const float *ropeR, *ropeC, *l2f, *l2b;
    __device__ __forceinline__ void operator()(const f32x4 (&acc)[2][2][4][2], const Unit& u, int wr, int wc, int fr, int fq) const {
        const int pm = u.pm, pn = u.pn;
        if (u.x0 == 1) {
            const int h = pn >> 1, half = pn & 1, idx = pm * 8 + h;
#pragma unroll
            for (int ai = 0; ai < 2; ++ai)
#pragma unroll
                for (int m = 0; m < 4; ++m) {
                    const int dv = half * 256 + 128 * ai + 64 * wr + 16 * m + fr;
#pragma unroll
                    for (int bj = 0; bj < 2; ++bj)
                        *(u32x4*)(VS + (size_t)idx * VS_E + (size_t)dv * 768 + 128 * bj + 32 * wc + 8 * fq) = pack8(acc[ai][bj][m][0], acc[ai][bj][m][1]);
                }
            return;
        }
        if (pn < 16) {
            const int h = pn & 7; const bool isK = pn >= 8; const int idx = pm * 8 + h;
            const bool lat = pm < 64; const int pos0 = (pm & 31) * 256;
            const float lf = l2f[h], lb = l2b[h];
            const int i0 = 16 * wc + 4 * fq;
            f32x4 cR[2][2], cC[4][2];
#pragma unroll
            for (int ai = 0; ai < 2; ++ai) { const float* tab = ropeR + (size_t)((pos0 >> 6) + 2 * ai + wr) * 128 + 2 * i0; cR[ai][0] = *(const f32x4*)(tab); cR[ai][1] = *(const f32x4*)(tab + 4); }
#pragma unroll
            for (int m = 0; m < 4; ++m) { const float* tab = ropeC + (size_t)(16 * m + fr) * 128 + 2 * i0; cC[m][0] = *(const f32x4*)(tab); cC[m][1] = *(const f32x4*)(tab + 4); }
#pragma unroll
            for (int ai = 0; ai < 2; ++ai)
#pragma unroll
                for (int m = 0; m < 4; ++m) {
                    const int p = 128 * ai + 64 * wr + 16 * m + fr;
                    const float d1 = isK ? __builtin_amdgcn_exp2f(lf * (float)(255 - p)) * 0.0625f : __builtin_amdgcn_exp2f(lf * (float)(p + 1));
                    const float d2 = isK ? __builtin_amdgcn_exp2f(lb * (float)p) * 0.0625f : __builtin_amdgcn_exp2f(lb * (float)(256 - p));
#pragma unroll
                    for (int bj = 0; bj < 2; ++bj) {
                        const int dk0 = 128 * bj + 32 * wc + 8 * fq;
                        f32x4 v0 = acc[ai][bj][m][0], v1 = acc[ai][bj][m][1];
                        if (lat) {
                            const f32x4 c0 = (bj == 0) ? cR[ai][0] : cC[m][0], c1 = (bj == 0) ? cR[ai][1] : cC[m][1];
                            f32x4 r0, r1;
                            r0[0] = v0[0] * c0[0] - v0[1] * c0[1]; r0[1] = v0[0] * c0[1] + v0[1] * c0[0];
                            r0[2] = v0[2] * c0[2] - v0[3] * c0[3]; r0[3] = v0[2] * c0[3] + v0[3] * c0[2];
                            r1[0] = v1[0] * c1[0] - v1[1] * c1[1]; r1[1] = v1[0] * c1[1] + v1[1] * c1[0];
                            r1[2] = v1[2] * c1[2] - v1[3] * c1[3]; r1[3] = v1[2] * c1[3] + v1[3] * c1[2];
                            v0 = r0; v1 = r1;
                        }
                        if (!isK) {
                            bf16* row = PQ + (size_t)idx * PQ_E + (size_t)p * 768 + dk0;
                            *(u32x4*)(row + 256) = pack8(v0 * d1, v1 * d1);
                            *(u32x4*)(row + 512) = pack8(v0 * d2, v1 * d2);
                        } else {
                            *(u32x4*)(Kr + (size_t)idx * KR_E + (size_t)p * 256 + dk0) = pack8(v0 * 0.0625f, v1 * 0.0625f);
                            bf16* tf = Kdtf + (size_t)idx * KR_E + (size_t)dk0 * 256 + p;
                            bf16* tb = Kdtb + (size_t)idx * KR_E + (size_t)dk0 * 256 + p;
#pragma unroll
                            for (int j = 0; j < 4; ++j) {
                                const unsigned pf = cvt_pk_bf16(v0[j] * d1, v1[j] * d1), pb = cvt_pk_bf16(v0[j] * d2, v1[j] * d2);
                                tf[(size_t)j * 256] = (bf16)(pf & 0xffffu); tf[(size_t)(4 + j) * 256] = (bf16)(pf >> 16);
                                tb[(size_t)j * 256] = (bf16)(pb & 0xffffu); tb[(size_t)(4 + j) * 256] = (bf16)(pb >> 16);
                            }
                        }
                    }
                }
        } else {
            const int gc0 = (pn - 32) * 256;
#pragma unroll
            for (int ai = 0; ai < 2; ++ai)
#pragma unroll
                for (int m = 0; m < 4; ++m) {
                    const int r = 256 * pm + 128 * ai + 64 * wr + 16 * m + fr;
#pragma unroll
                    for (int bj = 0; bj < 2; ++bj) {
                        const int c = gc0 + 128 * bj + 32 * wc + 8 * fq;
                        f32x4 v0 = acc[ai][bj][m][0], v1 = acc[ai][bj][m][1];
                        *(u32x4*)(Gs + (size_t)r * VD + c) = pack8(v0, v1);
                        asm volatile("" ::: "memory");
                    }
                }
        }
    }
};
struct EpiRet3 {
    static constexpr bool PERM = true;
    bf16 *PQ, *U; const float *l2f, *l2b;
    __device__ __forceinline__ void operator()(const f32x4 (&acc)[2][2][4][2], const Unit& u, int wr, int wc, int fr, int fq) const {
        const int idx = u.pm;
        if (u.x0 == 0) {
            const int h = idx & 7; const float lf = l2f[h], lb = l2b[h];
#pragma unroll
            for (int ai = 0; ai < 2; ++ai)
#pragma unroll
                for (int m = 0; m < 4; ++m) {
                    const int p = 128 * ai + 64 * wr + 16 * m + fr;
#pragma unroll
                    for (int bj = 0; bj < 2; ++bj) {
                        const int c0 = 128 * bj + 32 * wc + 8 * fq;
                        u32x4 w;
#pragma unroll
                        for (int n = 0; n < 2; ++n) {
                            f32x4 v = acc[ai][bj][m][n];
#pragma unroll
                            for (int j = 0; j < 4; ++j) { const int cc = c0 + 4 * n + j, d = p - cc;
                                v[j] *= __builtin_amdgcn_exp2f(d >= 0 ? -lf * (float)(cc + 1) : lb * (float)(-d) - lf * (float)(p + 1)); }
                            const unsigned q0 = cvt_pk_bf16(v[0], v[1]), q1 = cvt_pk_bf16(v[2], v[3]);
                            if (n == 0) { w.x = q0; w.y = q1; } else { w.z = q0; w.w = q1; }
                        }
                        *(u32x4*)(PQ + (size_t)idx * PQ_E + (size_t)p * 768 + c0) = w;
                        asm volatile("" ::: "memory");
                    }
                }
        } else {
            const int dir = u.x1 >> 1, half = u.x1 & 1;
            bf16* base = U + ((size_t)idx * 2 + dir) * U_E;
#pragma unroll
            for (int ai = 0; ai < 2; ++ai)
#pragma unroll
                for (int m = 0; m < 4; ++m) {
                    const int dv = half * 256 + 128 * ai + 64 * wr + 16 * m + fr;
#pragma unroll
                    for (int bj = 0; bj < 2; ++bj) {
                        const int c0 = 128 * bj + 32 * wc + 8 * fq;
                        *(u32x4*)(base + (size_t)dv * 256 + c0) = pack8(acc[ai][bj][m][0], acc[ai][bj][m][1]);
                        asm volatile("" ::: "memory");
                    }
                }
        }
    }
};
struct EpiO {
    static constexpr bool PERM = true;
    bf16* O;
    __device__ __forceinline__ void operator()(const f32x4 (&acc)[2][2][4][2], const Unit& u, int wr, int wc, int fr, int fq) const {
        const int pm = u.pm >> 3, h = u.pm & 7, cb = h * 512 + u.pn * 256;
#pragma unroll
        for (int ai = 0; ai < 2; ++ai)
#pragma unroll
            for (int m = 0; m < 4; ++m) {
                const int r = 256 * pm + 128 * ai + 64 * wr + 16 * m + fr;
#pragma unroll
                for (int bj = 0; bj < 2; ++bj)
                    *(u32x4*)(O + (size_t)r * VD + cb + 128 * bj + 32 * wc + 8 * fq) = pack8(acc[ai][bj][m][0], acc[ai][bj][m][1]);
            }
    }
};
struct EpiResid {
    static constexpr bool PERM = false;
    float* R1; const float* xa; const float* xb; int nsplit; const float* gate; const float* cscale; int has_scale;
    __device__ __forceinline__ void operator()(const f32x4 (&acc)[2][2][4][2], const Unit& u, int wr, int wc, int fr, int fq) const {
        const int cb = u.pn * (has_scale ? 1 : 256);
        const int r0 = 256 * u.pm;
        const int v = (r0 < NLAT) ? (r0 >> 13) : 2;
        const float* gr = gate + (size_t)v * MODW;
        f32x4 gv[2][2];
#pragma unroll
        for (int bj = 0; bj < 2; ++bj)
#pragma unroll
            for (int n = 0; n < 2; ++n) { const int c = cb + 128 * bj + 32 * wc + 16 * n + 4 * fq; gv[bj][n] = *(const f32x4*)(gr + c); if (has_scale) gv[bj][n] = gv[bj][n] * *(const f32x4*)(cscale + c); }
#pragma unroll
        for (int ai = 0; ai < 2; ++ai) {
            f32x4 xv[4][2][2];
#pragma unroll
            for (int m = 0; m < 4; ++m) {
                const int r = r0 + 128 * ai + 64 * wr + 16 * m + fr;
                const float* xr = (r < nsplit) ? xa + (size_t)r * D : xb + (size_t)(r - nsplit) * D;
#pragma unroll
                for (int bj = 0; bj < 2; ++bj)
#pragma unroll
                    for (int n = 0; n < 2; ++n) xv[m][bj][n] = *(const f32x4*)(xr + cb + 128 * bj + 32 * wc + 16 * n + 4 * fq);
            }
#pragma unroll
            for (int m = 0; m < 4; ++m) {
                const int r = r0 + 128 * ai + 64 * wr + 16 * m + fr;
#pragma unroll
                for (int bj = 0; bj < 2; ++bj)
#pragma unroll
                    for (int n = 0; n < 2; ++n) *(f32x4*)(R1 + (size_t)r * D + cb + 128 * bj + 32 * wc + 16 * n + 4 * fq) = xv[m][bj][n] * ALPHA + gv[bj][n] * acc[ai][bj][m][n];
            }
        }
    }
};
struct EpiMoe1 {
    static constexpr bool PERM = true;
    bf16* ACT;
    __device__ __forceinline__ void operator()(const f32x4 (&acc)[2][2][4][2], const Unit& u, int wr, int wc, int fr, int fq) const {
#pragma unroll
        for (int ai = 0; ai < 2; ++ai)
#pragma unroll
            for (int m = 0; m < 4; ++m) {
                const int r = u.pm + 128 * ai + 64 * wr + 16 * m + fr;
                f32x4 v0, v1;
#pragma unroll
                for (int j = 0; j < 4; ++j) { v0[j] = silu_f(acc[ai][0][m][0][j]) * acc[ai][1][m][0][j]; v1[j] = silu_f(acc[ai][0][m][1][j]) * acc[ai][1][m][1][j]; }
                *(u32x4*)(ACT + (size_t)r * ED + u.pn * 128 + 32 * wc + 8 * fq) = pack8(v0, v1);
            }
    }
};
constexpr float Y_SCALE = 64.0f;
struct EpiMoe2 {
    static constexpr bool PERM = true;
    unsigned char* Y;
    __device__ __forceinline__ void operator()(const f32x4 (&acc)[2][2][4][2], const Unit& u, int wr, int wc, int fr, int fq) const {
#pragma unroll
        for (int ai = 0; ai < 2; ++ai)
#pragma unroll
            for (int m = 0; m < 4; ++m) {
                const int p = 128 * ai + 64 * wr + 16 * m + fr;
#pragma unroll
                for (int bj = 0; bj < 2; ++bj) {
                    f32x4 v0 = acc[ai][bj][m][0], v1 = acc[ai][bj][m][1];
#pragma unroll
                    for (int j = 0; j < 4; ++j) { v0[j] = __builtin_amdgcn_fmed3f(v0[j], -448.0f, 448.0f); v1[j] = __builtin_amdgcn_fmed3f(v1[j], -448.0f, 448.0f); }
                    int w0 = 0, w1 = 0;
                    w0 = __builtin_amdgcn_cvt_pk_fp8_f32(v0[0], v0[1], w0, false); w0 = __builtin_amdgcn_cvt_pk_fp8_f32(v0[2], v0[3], w0, true);
                    w1 = __builtin_amdgcn_cvt_pk_fp8_f32(v1[0], v1[1], w1, false); w1 = __builtin_amdgcn_cvt_pk_fp8_f32(v1[2], v1[3], w1, true);
                    u32x2 w; w.x = (unsigned)w0; w.y = (unsigned)w1;
                    *(u32x2*)(Y + (size_t)(u.pm + p) * D + 256 * u.pn + 128 * bj + 32 * wc + 8 * fq) = w;
                }
            }
    }
};

struct ConvJob { const float* src; bf16* dst; int ldw, ldt; float scale; };
__device__ __forceinline__ void conv_load(const ConvJob& j, f32x4 (&v)[16], int lane) {
    const float* src = j.src + (size_t)(lane >> 4) * j.ldw + (lane & 15) * 4;
#pragma unroll
    for (int i = 0; i < 16; ++i) v[i] = *(const f32x4*)(src + (size_t)(4 * i) * j.ldw);
}
__device__ __forceinline__ void conv_store(const ConvJob& j, const f32x4 (&v)[16], LAS float* scr, int lane) {
#pragma unroll
    for (int i = 0; i < 16; ++i) { LAS float* s = scr + (4 * i + (lane >> 4)) * 65 + (lane & 15) * 4; s[0] = v[i][0]; s[1] = v[i][1]; s[2] = v[i][2]; s[3] = v[i][3]; }
    LDS_WAIT(); asm volatile("" ::: "memory");
    const int c = lane & 7;
#pragma unroll
    for (int q = 0; q < 8; ++q) {
        const int n = (lane >> 3) + 8 * q; const LAS float* s = scr + (8 * c) * 65 + n;
        const float sc_ = j.scale;
        u32x4 o; o.x = cvt_pk_bf16(s[0 * 65] * sc_, s[1 * 65] * sc_); o.y = cvt_pk_bf16(s[2 * 65] * sc_, s[3 * 65] * sc_); o.z = cvt_pk_bf16(s[4 * 65] * sc_, s[5 * 65] * sc_); o.w = cvt_pk_bf16(s[6 * 65] * sc_, s[7 * 65] * sc_);
        *(u32x4*)(j.dst + (size_t)n * j.ldt + 8 * c) = o;
    }
    LDS_WAIT(); asm volatile("" ::: "memory");
}
struct JobP0 {
    const float *win, *wout, *wpool; bf16 *WINd, *WOUTd, *WPOOLd;
    static constexpr int N = 32 * 192 + 64 * 32 + 4 * 64;
    __device__ __forceinline__ ConvJob operator()(int r) const {
        ConvJob j; j.scale = 1.0f;
        if (r < 32 * 192) { const int kb = r / 192, nb = r % 192; j.src = win + (size_t)kb * 64 * RIN + nb * 64; j.ldw = RIN; j.dst = WINd + (size_t)nb * 64 * D + kb * 64; j.ldt = D; return j; }
        r -= 32 * 192;
        if (r < 64 * 32) { const int kb = r / 32, nb = r % 32; j.src = wout + (size_t)kb * 64 * D + nb * 64; j.ldw = D; j.dst = WOUTd + (size_t)nb * 64 * VD + kb * 64; j.ldt = VD; return j; }
        r -= 64 * 32;
        { const int g = r >> 6, t = r & 63, kb = t >> 3, nb = t & 7; j.src = wpool + (size_t)g * 512 * 512 + (size_t)kb * 64 * 512 + nb * 64; j.ldw = 512; j.dst = WPOOLd + (size_t)g * 512 * 512 + (size_t)nb * 64 * 512 + kb * 64; j.ldt = 512; return j; }
    }
};
struct JobExp {
    const float *eg, *eu, *ed, *sg, *su, *sd; bf16 *W13, *W2; int layer, mode;
    __device__ __forceinline__ int count() const { return NE1 * (mode == 0 ? 512 : mode == 1 ? 256 : 768); }
    __device__ __forceinline__ ConvJob operator()(int it) const {
        const int per = (mode == 0 ? 512 : mode == 1 ? 256 : 768);
        const int e = it / per; int r = it - e * per; if (mode == 1) r += 512;
        const int mat = r >> 8, t = r & 255;
        ConvJob j; j.scale = (mat < 2) ? 1.0f : 64.0f;
        if (mat < 2) {
            const float* We = mat ? eu : eg; const float* Ws = mat ? su : sg;
            const float* W = (e < NE) ? We + ((size_t)layer * NE + e) * (size_t)(D * ED) : Ws + (size_t)layer * (D * ED);
            const int kb = t >> 3, n0 = (t & 7) * 64;
            j.src = W + (size_t)kb * 64 * ED + n0; j.ldw = ED;
            j.dst = W13 + (size_t)e * W13_E + (size_t)((n0 >> 7) * 256 + (n0 & 127) + mat * 128) * D + kb * 64; j.ldt = D;
        } else {
            const float* W = (e < NE) ? ed + ((size_t)layer * NE + e) * (size_t)(ED * D) : sd + (size_t)layer * (ED * D);
            const int kb = t >> 5, nb = t & 31;
            j.src = W + (size_t)kb * 64 * D + nb * 64; j.ldw = D;
            j.dst = W2 + (size_t)e * W2_E + (size_t)nb * 64 * ED + kb * 64; j.ldt = ED;
        }
        return j;
    }
};
struct JobTail {
    JobExp a, b; int from;
    __device__ __forceinline__ int count() const { return (a.count() - from) + b.count(); }
    __device__ __forceinline__ ConvJob operator()(int it) const { const int na = a.count() - from; return it < na ? a(from + it) : b(it - na); }
};
template <class Dec>
__device__ __forceinline__ void conv_loop(const Dec& dec, int first, int stride, int n, LAS float* scr, int lane) {
    for (int it = first; it < n; it += 3 * stride) {
        const bool h1 = it + stride < n, h2 = it + 2 * stride < n;
        const ConvJob j0 = dec(it); ConvJob j1 = j0, j2 = j0;
        f32x4 v0[16], v1[16], v2[16];
        conv_load(j0, v0, lane);
        if (h1) { j1 = dec(it + stride); conv_load(j1, v1, lane); }
        if (h2) { j2 = dec(it + 2 * stride); conv_load(j2, v2, lane); }
        conv_store(j0, v0, scr, lane);
        if (h1) conv_store(j1, v1, scr, lane);
        if (h2) conv_store(j2, v2, scr, lane);
    }
}
struct Roles { int is_conv, g_rank, g_count, c_rank, c_count; };
__device__ __forceinline__ Roles make_roles(const Frame& F, int nper) {
    Roles r; const int per = F.G / 8, bx = blockIdx.x, x = bx % 8, rix = bx / 8;
    if (F.G % 8 != 0 || nper <= 0 || nper >= per) { r.is_conv = 0; r.g_rank = F.vcu; r.g_count = F.G; r.c_rank = F.vcu; r.c_count = F.G; return r; }
    r.is_conv = rix >= per - nper; r.g_rank = x * (per - nper) + rix; r.g_count = 8 * (per - nper); r.c_rank = x * nper + (rix - (per - nper)); r.c_count = 8 * nper;
    return r;
}
__device__ __forceinline__ void sincos_d(double a, float& s, float& c) {
    const double TWO_PI = 6.283185307179586476925286766559;
    const double k = __builtin_rint(a / TWO_PI);
    const double r = a - k * TWO_PI;
    const double r2 = r * r;
    double ts = r, tc = 1.0, ss = r, cc = 1.0;
#pragma unroll
    for (int i = 1; i <= 14; ++i) { tc = -tc * r2 / (double)((2 * i - 1) * (2 * i)); ts = -ts * r2 / (double)((2 * i) * (2 * i + 1)); cc += tc; ss += ts; }
    s = (float)ss; c = (float)cc;
}

__device__ __forceinline__ void build_moe_tab(Frame& F, int layer, int ntok) {
    int tid_ = (int)threadIdx.x; asm volatile("" : "+v"(tid_));
    if (tid_ < 64) {
        const int cnt = (int)__hip_atomic_load(F.ctl + CW_CNT + (layer * 64 + tid_) * 64, RLX_AGENT);
        F.TAB[66 + tid_] = cnt;
        const int pn = (cnt + 255) >> 8;
        int incl = pn;
#pragma unroll
        for (int o = 1; o < 64; o <<= 1) { const int t = __shfl_up(incl, o); if ((tid_ & 63) >= o) incl += t; }
        F.TAB[tid_ + 1] = incl;
        if (tid_ == 0) F.TAB[0] = 0;
        if (tid_ == 63) F.TAB[65] = incl + ntok / 256;
    }
    LDS_WAIT();
    __syncthreads();
}

struct Args { const float* in[24]; float* out; unsigned char* ws; int ph_lo, ph_hi; };

#ifndef PH_MASK
#define PH_MASK 0x3ffff
#endif
#define IN(k) ((((PH_MASK) >> ((k) >= 14 ? (k) - 6 : (k))) & 1) && lo <= (k) && (k) < hi)
#define SEAM(k) do { if (IN(k) && IN((k) + 1)) xcd_barrier(bar); } while (0)

#define MOD ((float*)(ws + WS_MOD))
#define ROPER ((float*)(ws + WS_ROPE))
#define ROPEC (ROPER + 128 * 64 * 2)
#define L2F ((float*)(ws + WS_L2G))
#define L2B (L2F + 8)
#define RW ((bf16*)(ws + WS_RW))
#define TOKE ((int*)(ws + WS_TOKE))
#define TOKP ((int*)(ws + WS_TOKP))
#define ROWL ((int*)(ws + WS_ROWL))
#define SLOTG ((float*)(ws + WS_SLOTG))
#define WIN ((bf16*)(ws + WS_WIN))
#define WOUT ((bf16*)(ws + WS_WOUT))
#define WPOOL ((bf16*)(ws + WS_WPOOL))
#define HB ((bf16*)(ws + WS_HB))
#define XL ((float*)(ws + WS_XL))
#define R1 ((float*)(ws + WS_R1))
#define KR ((bf16*)(ws + WS_KR))
#define KDTF ((bf16*)(ws + WS_KDTF))
#define KDTB ((bf16*)(ws + WS_KDTB))
#define PQ ((bf16*)(ws + WS_PQ))
#define VS ((bf16*)(ws + WS_VS))
#define UB ((bf16*)(ws + WS_U))
#define GS ((bf16*)(ws + WS_GS))
#define OB ((bf16*)(ws + WS_O))
#define A2 ((bf16*)(ws + WS_A2))
#define ACT ((bf16*)(ws + WS_ACT))
#define YB ((unsigned char*)(ws + WS_Y))
template <int layer>
__device__ __forceinline__ void layer_tail(Frame& F, const Args& args, const int lo, const int hi, const XcdBarrier& bar) {
    unsigned char* const ws = args.ws;
    const int gw = F.vcu * NWAVES + F.wave, NGW = F.G * NWAVES;
    LAS float* scr = (LAS float*)(F.lds + F.wave * 16640);
        const int ntok = NLAT;
        const int pb = layer ? 14 : 8;
        const float* modL = MOD + (size_t)layer * 3 * MODW;
        bf16* W13 = (bf16*)(ws + (layer ? WS_W13_1 : WS_W13_0)); bf16* W2 = (bf16*)(ws + (layer ? WS_W2_1 : WS_W2_0));
        unsigned* cntw = F.ctl + CW_CNT + layer * 64 * 64;

        if (layer == 1) {
            if (IN(12)) {
                for (int it = gw; it < 256 * 8; it += NGW) {
                    const int grow = it >> 3, ch = it & 7, c = ch * 256 + F.lane * 4;
                    const int wdw = 2 << (c >> 9), hw = wdw >> 1;
                    const float* md = MOD + (size_t)(3 + (grow >> 7)) * MODW;
                    const f32x4 sh = *(const f32x4*)(md + c), sc = *(const f32x4*)(md + D + c) + 1.0f;
                    const float* xb = XL + (size_t)grow * 64 * D + c;
                    f32x4 sum = {0.f, 0.f, 0.f, 0.f};
                    for (int j = 0; j < hw; ++j) sum += *(const f32x4*)(xb + (size_t)j * D) * sc + sh;
#pragma unroll 4
                    for (int t = 0; t < 64; ++t) {
                        const int lo2 = (t - hw) < 0 ? 0 : (t - hw), hi2 = (t + hw) > 64 ? 64 : (t + hw);
                        const f32x4 self = *(const f32x4*)(xb + (size_t)t * D) * sc + sh;
                        const f32x4 p = sum * (1.0f / (float)(hi2 - lo2)) - self;
                        u32x2 w; w.x = cvt_pk_bf16(p[0], p[1]); w.y = cvt_pk_bf16(p[2], p[3]);
                        *(u32x2*)(HB + ((size_t)grow * 64 + t) * D + c) = w;
                        if (t + hw < 64) sum += *(const f32x4*)(xb + (size_t)(t + hw) * D) * sc + sh;
                        if (t - hw >= 0) sum -= *(const f32x4*)(xb + (size_t)(t - hw) * D) * sc + sh;
                    }
                }
            }
            SEAM(12);
            if (IN(13)) {
                SchedPool S{(const char*)HB, (const char*)WPOOL, F.G, F.vcu};
                EpiResid E{R1, XL, XL, NLAT, MOD + (size_t)3 * MODW + 2 * D, args.in[15], 1};
                gemm_run<4>(F.lds, Dims{D, 512, 512}, S, E);
            }
            SEAM(13);
        }

        if (IN(pb)) {
            const float* lng = args.in[6] + (size_t)layer * D; const float* lnb = args.in[7] + (size_t)layer * D;
            const bf16* rwh = RW + (size_t)(layer * 2) * NE * D; const bf16* rwl = rwh + (size_t)NE * D;
            const float* rbias = args.in[17] + layer * NE;
            LAS float* PART = (LAS float*)F.lds;
            bf16* HL = (bf16*)(ws + WS_Y);
            const int fr = F.lane & 15, fq = F.lane >> 4;
            const float rb = rbias[F.lane];
            LAS int* LCNT = F.TAB + 512; LAS int* LBASE = F.TAB + 576; LAS int* ASG = F.TAB + 640; LAS float* ASGG = (LAS float*)(F.TAB + 1152);
            const int nblocks = ntok / 16;
            for (int blk0 = F.vcu; blk0 < nblocks; blk0 += 4 * F.G) {
                int nst = 0;
#pragma unroll
                for (int q = 0; q < 4; ++q) nst += (blk0 + q * F.G < nblocks) ? 1 : 0;
                if (F.tid < 64) LCNT[F.tid] = 0;
                f32x4 xa[2][8];
#pragma unroll
                for (int rr = 0; rr < 2; ++rr)
#pragma unroll
                    for (int j = 0; j < 8; ++j) xa[rr][j] = *(const f32x4*)(R1 + (size_t)(blk0 * 16 + 2 * F.wave + rr) * D + j * 256 + F.lane * 4);
                for (int st = 0; st < nst; ++st) {
                    const int r0 = (blk0 + st * F.G) * 16;
                    const float* md = modL + (size_t)(r0 >> 13) * MODW;
                    float rs2[2];
#pragma unroll
                    for (int rr = 0; rr < 2; ++rr) {
                        float sm = 0.f;
#pragma unroll
                        for (int j = 0; j < 8; ++j) sm += (xa[rr][j][0] + xa[rr][j][1]) + (xa[rr][j][2] + xa[rr][j][3]);
                        const float mu = wave_sum(sm) * (1.0f / D); float sq = 0.f;
#pragma unroll
                        for (int j = 0; j < 8; ++j) { xa[rr][j] = xa[rr][j] - mu; sq += (xa[rr][j][0] * xa[rr][j][0] + xa[rr][j][1] * xa[rr][j][1]) + (xa[rr][j][2] * xa[rr][j][2] + xa[rr][j][3] * xa[rr][j][3]); }
                        rs2[rr] = 1.0f / sqrtf(wave_sum(sq) * (1.0f / D) + LN_EPS);
                    }
#pragma unroll
                    for (int rr = 0; rr < 2; ++rr) {
                        const size_t ro = (size_t)(r0 + 2 * F.wave + rr) * D;
#pragma unroll
                        for (int jh = 0; jh < 8; jh += 4) {
                            f32x4 vg[4], vb[4], vsc[4], vsh[4];
#pragma unroll
                            for (int j2 = 0; j2 < 4; ++j2) { const int c = (jh + j2) * 256 + F.lane * 4; vg[j2] = *(const f32x4*)(lng + c); vb[j2] = *(const f32x4*)(lnb + c); vsc[j2] = *(const f32x4*)(md + 4 * D + c); vsh[j2] = *(const f32x4*)(md + 3 * D + c); }
#pragma unroll
                            for (int j2 = 0; j2 < 4; ++j2) {
                                const int j = jh + j2, c = j * 256 + F.lane * 4;
                                const f32x4 y = xa[rr][j] * rs2[rr] * vg[j2] + vb[j2];
                                *(f32x4*)(XL + ro + c) = y;
                                const f32x4 hh = y * (vsc[j2] + 1.0f) + vsh[j2];
                                u32x2 wh, wl;
                                const unsigned b0 = f2bf(hh[0]), b1 = f2bf(hh[1]), b2 = f2bf(hh[2]), b3 = f2bf(hh[3]);
                                wh.x = b0 | (b1 << 16); wh.y = b2 | (b3 << 16);
                                wl.x = cvt_pk_bf16(hh[0] - bf2f(b0), hh[1] - bf2f(b1)); wl.y = cvt_pk_bf16(hh[2] - bf2f(b2), hh[3] - bf2f(b3));
                                *(u32x2*)(HB + ro + c) = wh;
                                *(u32x2*)(HL + ro + c) = wl;
                            }
                        }
                    }
                    {
                        const int nb = (st + 1 < nst) ? blk0 + (st + 1) * F.G : blk0 + st * F.G;
#pragma unroll
                        for (int rr = 0; rr < 2; ++rr)
#pragma unroll
                            for (int j = 0; j < 8; ++j) xa[rr][j] = *(const f32x4*)(R1 + (size_t)(nb * 16 + 2 * F.wave + rr) * D + j * 256 + F.lane * 4);
                    }
                }
                VM_WAIT(); LDS_WAIT(); __syncthreads();
                f32x4 lg[4][4];
#pragma unroll
                for (int st = 0; st < 4; ++st)
#pragma unroll
                    for (int j = 0; j < 4; ++j) lg[st][j] = (f32x4){0.f, 0.f, 0.f, 0.f};
#pragma unroll 2
                for (int ks = 0; ks < 8; ++ks) {
                    const int c = 256 * F.wave + ks * 32 + fq * 8;
                    bf16x8 bh[4], bl[4];
#pragma unroll
                    for (int j = 0; j < 4; ++j) { bh[j] = *(const bf16x8*)(rwh + (size_t)(16 * j + fr) * D + c); bl[j] = *(const bf16x8*)(rwl + (size_t)(16 * j + fr) * D + c); }
#pragma unroll
                    for (int st = 0; st < 4; ++st) {
                        const int bb = (st < nst) ? blk0 + st * F.G : blk0;
                        const size_t ao = (size_t)(bb * 16 + fr) * D + c;
                        const bf16x8 ah = *(const bf16x8*)(HB + ao), al = *(const bf16x8*)(HL + ao);
#pragma unroll
                        for (int j = 0; j < 4; ++j) {
                            lg[st][j] = __builtin_amdgcn_mfma_f32_16x16x32_bf16(ah, bh[j], lg[st][j], 0, 0, 0);
                            lg[st][j] = __builtin_amdgcn_mfma_f32_16x16x32_bf16(al, bh[j], lg[st][j], 0, 0, 0);
                            lg[st][j] = __builtin_amdgcn_mfma_f32_16x16x32_bf16(ah, bl[j], lg[st][j], 0, 0, 0);
                        }
                    }
                }
#pragma unroll
                for (int st = 0; st < 4; ++st)
#pragma unroll
                    for (int j = 0; j < 4; ++j)
#pragma unroll
                        for (int q = 0; q < 4; ++q) PART[F.wave * 4096 + (st * 16 + 4 * fq + q) * 64 + 16 * j + fr] = lg[st][j][q];
                LDS_WAIT(); __syncthreads();
                for (int tt = 0; tt < 8; ++tt) {
                    const int q = 8 * F.wave + tt;
                    if ((q >> 4) >= nst) break;
                    float logit = 0.f;
#pragma unroll
                    for (int w2 = 0; w2 < 8; ++w2) logit += PART[w2 * 4096 + q * 64 + F.lane];
                    const float score = 1.0f / (1.0f + __expf(-logit));
                    const float bsd = score + rb;
                    float m1 = bsd;
                    m1 = fmaxf(m1, __shfl_xor(m1, 1)); m1 = fmaxf(m1, __shfl_xor(m1, 2)); m1 = fmaxf(m1, __shfl_xor(m1, 4));
                    const unsigned long long eqm = __ballot(bsd == m1);
                    const unsigned seg = (unsigned)(eqm >> (F.lane & ~7)) & 0xffu;
                    const int first = __builtin_ctz(seg);
                    float m2 = ((F.lane & 7) == first) ? -__builtin_inff() : bsd;
                    m2 = fmaxf(m2, __shfl_xor(m2, 1)); m2 = fmaxf(m2, __shfl_xor(m2, 2)); m2 = fmaxf(m2, __shfl_xor(m2, 4));
                    const float gs = m1 + m2;
                    int grank = 0; const int myg = F.lane >> 3;
#pragma unroll
                    for (int g2 = 0; g2 < 8; ++g2) { const float o = __shfl(gs, g2 * 8); grank += (o > gs || (o == gs && g2 < myg)) ? 1 : 0; }
                    const float mv = (grank < 4) ? bsd : -__builtin_inff();
                    int rank = 0;
                    unsigned long long gbits = __ballot(grank < 4) & 0x0101010101010101ull;
#pragma unroll 1
                    for (int it = 0; it < 4; ++it) {
                        const int b0 = __builtin_amdgcn_readfirstlane((int)__builtin_ctzll(gbits)); gbits &= gbits - 1;
#pragma unroll
                        for (int j2 = 0; j2 < 8; ++j2) { const int e2 = b0 + j2; const float o = __builtin_bit_cast(float, __builtin_amdgcn_readlane(__builtin_bit_cast(int, mv), e2)); rank += (o > mv || (o == mv && e2 < F.lane)) ? 1 : 0; }
                    }
                    const bool sel = rank < 8;
                    const float ssum = wave_sum(sel ? score : 0.f);
                    if (sel) {
                        const float gate = score / ssum * ROUTED_SCALE;
                        const int local = __hip_atomic_fetch_add(LCNT + F.lane, 1, __ATOMIC_RELAXED, __HIP_MEMORY_SCOPE_WORKGROUP);
                        ASG[q * 8 + rank] = F.lane | (local << 8); ASGG[q * 8 + rank] = gate;
                    }
                }
                LDS_WAIT(); __syncthreads();
                if (F.tid < 64) { const int c = LCNT[F.tid]; LBASE[F.tid] = c ? (int)__hip_atomic_fetch_add(cntw + F.tid * 64, (unsigned)c, RLX_AGENT) : 0; }
                LDS_WAIT(); __syncthreads();
                if (F.tid < nst * 128) {
                    const int q = F.tid >> 3, rank = F.tid & 7, a = ASG[F.tid], e = a & 0xff, pos = LBASE[e] + (a >> 8);
                    const int t = (blk0 + (q >> 4) * F.G) * 16 + (q & 15);
                    ROWL[(size_t)e * CAP + pos] = t; SLOTG[(size_t)t * 8 + rank] = ASGG[F.tid];
                    TOKE[(size_t)t * 8 + rank] = e; TOKP[(size_t)t * 8 + rank] = pos;
                }
                LDS_WAIT(); __syncthreads();
            }
            if (layer == 0 && (CONV_P9 == 0 || CONV_P10 == 0 || F.G % 8 != 0 || CONV_P9 >= F.G / 8)) {
                __syncthreads();
                JobExp dec{args.in[18], args.in[19], args.in[20], args.in[21], args.in[22], args.in[23], (bf16*)(ws + WS_W13_1), (bf16*)(ws + WS_W2_1), 1, 2};
                conv_loop(dec, gw, NGW, dec.count(), scr, F.lane);
            }
        }
        SEAM(pb);

        if (IN(pb + 1)) {
            build_moe_tab(F, layer, ntok);
            const Roles R = make_roles(F, (layer == 0 && CONV_P10 > 0) ? CONV_P9 : 0);
            if (!R.is_conv) {
                SchedMoE S{F.TAB, (const char*)HB, (const char*)W13, ROWL, 4, D * 2, R.g_count, R.g_rank, 1, W13_E * 2, (size_t)256 * D * 2};
                EpiMoe1 E{ACT};
                gemm_run<5, EpiMoe1, SchedMoE, true>(F.lds, Dims{D, D, D}, S, E);
            } else {
                JobExp dec{args.in[18], args.in[19], args.in[20], args.in[21], args.in[22], args.in[23], (bf16*)(ws + WS_W13_1), (bf16*)(ws + WS_W2_1), 1, 0};
                conv_loop(dec, R.c_rank * NWAVES + F.wave, R.c_count * NWAVES, W13_SPLIT < dec.count() ? W13_SPLIT : dec.count(), scr, F.lane);
            }
            __syncthreads();
        }
        SEAM(pb + 1);

        if (IN(pb + 2)) {
            build_moe_tab(F, layer, ntok);
            const Roles R = make_roles(F, (layer == 0 && CONV_P9 > 0) ? CONV_P10 : 0);
            if (!R.is_conv) {
                SchedMoE S{F.TAB, (const char*)ACT, (const char*)W2, ROWL, 8, ED * 2, R.g_count, R.g_rank, 0, W2_E * 2, (size_t)256 * ED * 2};
                EpiMoe2 E{YB};
                gemm_run<6>(F.lds, Dims{ED, ED, ED}, S, E);
            } else {
                JobExp d0{args.in[18], args.in[19], args.in[20], args.in[21], args.in[22], args.in[23], (bf16*)(ws + WS_W13_1), (bf16*)(ws + WS_W2_1), 1, 0};
                JobExp d1{args.in[18], args.in[19], args.in[20], args.in[21], args.in[22], args.in[23], (bf16*)(ws + WS_W13_1), (bf16*)(ws + WS_W2_1), 1, 1};
                JobTail dec{d0, d1, W13_SPLIT < d0.count() ? W13_SPLIT : d0.count()};
                conv_loop(dec, R.c_rank * NWAVES + F.wave, R.c_count * NWAVES, dec.count(), scr, F.lane);
            }
            __syncthreads();
        }
        SEAM(pb + 2);

        if (IN(pb + 3)) {
            build_moe_tab(F, layer, ntok);
            const float* lng = args.in[8] + (size_t)layer * D; const float* lnb = args.in[9] + (size_t)layer * D;
            float* dst = layer ? F.out : XL;
            int eN[8], pN[8]; float gN[8], gC[8];
            u32x2 yv[4][9]; f32x4 xr_[8];
            {
                const int t = (gw < ntok) ? gw : 0, t1 = (t + NGW < ntok) ? t + NGW : t;
                int slot[9];
#pragma unroll
                for (int k = 0; k < 8; ++k) slot[k] = F.TAB[TOKE[(size_t)t * 8 + k]] * 256 + TOKP[(size_t)t * 8 + k];
                slot[8] = F.TAB[64] * 256 + t;
#pragma unroll
                for (int j = 0; j < 4; ++j) {
                    const int c = j * 512 + F.lane * 8;
#pragma unroll
                    for (int k = 0; k < 9; ++k) yv[j][k] = *(const u32x2*)(YB + (size_t)slot[k] * D + c);
                    xr_[2 * j] = *(const f32x4*)(XL + (size_t)t * D + c); xr_[2 * j + 1] = *(const f32x4*)(XL + (size_t)t * D + c + 4);
                }
#pragma unroll
                for (int k = 0; k < 8; ++k) { eN[k] = TOKE[(size_t)t1 * 8 + k]; pN[k] = TOKP[(size_t)t1 * 8 + k]; gN[k] = SLOTG[(size_t)t1 * 8 + k]; gC[k] = SLOTG[(size_t)t * 8 + k]; }
            }
            for (int t = gw; t < ntok; t += NGW) {
                const int v = (t < NLAT) ? (t >> 13) : 2;
                const float* g2 = modL + (size_t)v * MODW + 5 * D;
                f32x4 x[8]; float sm = 0.f;
#pragma unroll
                for (int j = 0; j < 4; ++j) {
                    const int c = j * 512 + F.lane * 8;
                    f32x4 f0 = {0.f, 0.f, 0.f, 0.f}, f1 = {0.f, 0.f, 0.f, 0.f};
#pragma unroll
                    for (int k = 0; k < 9; ++k) {
                        const u32x2 y2 = yv[j][k];
                        const float g = (k < 8) ? gC[k < 8 ? k : 0] : 1.0f;
                        f0[0] += g * __builtin_amdgcn_cvt_f32_fp8((int)y2.x, 0); f0[1] += g * __builtin_amdgcn_cvt_f32_fp8((int)y2.x, 1); f0[2] += g * __builtin_amdgcn_cvt_f32_fp8((int)y2.x, 2); f0[3] += g * __builtin_amdgcn_cvt_f32_fp8((int)y2.x, 3);
                        f1[0] += g * __builtin_amdgcn_cvt_f32_fp8((int)y2.y, 0); f1[1] += g * __builtin_amdgcn_cvt_f32_fp8((int)y2.y, 1); f1[2] += g * __builtin_amdgcn_cvt_f32_fp8((int)y2.y, 2); f1[3] += g * __builtin_amdgcn_cvt_f32_fp8((int)y2.y, 3);
                    }
                    x[2 * j] = xr_[2 * j] * ALPHA + *(const f32x4*)(g2 + c) * (f0 * (1.0f / Y_SCALE));
                    x[2 * j + 1] = xr_[2 * j + 1] * ALPHA + *(const f32x4*)(g2 + c + 4) * (f1 * (1.0f / Y_SCALE));
                    sm += (x[2 * j][0] + x[2 * j][1]) + (x[2 * j][2] + x[2 * j][3]) + (x[2 * j + 1][0] + x[2 * j + 1][1]) + (x[2 * j + 1][2] + x[2 * j + 1][3]);
                }
                const int tn = (t + NGW < ntok) ? t + NGW : t, tnn = (tn + NGW < ntok) ? tn + NGW : tn;
                {
                    int slot[9];
#pragma unroll
                    for (int k = 0; k < 8; ++k) slot[k] = F.TAB[eN[k]] * 256 + pN[k];
                    slot[8] = F.TAB[64] * 256 + tn;
#pragma unroll
                    for (int j = 0; j < 4; ++j) {
                        const int c = j * 512 + F.lane * 8;
#pragma unroll
                        for (int k = 0; k < 9; ++k) yv[j][k] = *(const u32x2*)(YB + (size_t)slot[k] * D + c);
                        xr_[2 * j] = *(const f32x4*)(XL + (size_t)tn * D + c); xr_[2 * j + 1] = *(const f32x4*)(XL + (size_t)tn * D + c + 4);
                    }
#pragma unroll
                    for (int k = 0; k < 8; ++k) { gC[k] = gN[k]; eN[k] = TOKE[(size_t)tnn * 8 + k]; pN[k] = TOKP[(size_t)tnn * 8 + k]; gN[k] = SLOTG[(size_t)tnn * 8 + k]; }
                }
                const float mu = wave_sum(sm) * (1.0f / D); float sq = 0.f;
#pragma unroll
                for (int j = 0; j < 8; ++j) { x[j] = x[j] - mu; sq += (x[j][0] * x[j][0] + x[j][1] * x[j][1]) + (x[j][2] * x[j][2] + x[j][3] * x[j][3]); }
                const float rstd = 1.0f / sqrtf(wave_sum(sq) * (1.0f / D) + LN_EPS);
#pragma unroll
                for (int j = 0; j < 4; ++j) {
                    const int c = j * 512 + F.lane * 8;
                    *(f32x4*)(dst + (size_t)t * D + c) = x[2 * j] * rstd * *(const f32x4*)(lng + c) + *(const f32x4*)(lnb + c);
                    *(f32x4*)(dst + (size_t)t * D + c + 4) = x[2 * j + 1] * rstd * *(const f32x4*)(lng + c + 4) + *(const f32x4*)(lnb + c + 4);
                }
            }
            __syncthreads();
        }
        SEAM(pb + 3);
    }

__global__ void __launch_bounds__(NWAVES * 64, 2) mk_fwd(Args args) {
    extern __shared__ __attribute__((aligned(16))) unsigned char lds_raw[];
    Frame F;
    F.lds = (LAS unsigned char*)lds_raw;
    F.TAB = (LAS int*)(F.lds + LDSCTL_OFF);
    F.MISC = (volatile LAS unsigned*)(F.lds + LDSCTL_OFF + 1024);
    F.tid = threadIdx.x; F.lane = F.tid & 63; F.wave = __builtin_amdgcn_readfirstlane(F.tid >> 6);
    F.G = gridDim.x; { const int bx = blockIdx.x; F.vcu = (F.G % 8 == 0) ? (bx % 8) * (F.G / 8) + bx / 8 : bx; }
    F.ws = args.ws; F.ctl = (unsigned*)(args.ws + WS_CTL); F.out = args.out;
    for (int u = F.tid; u < (LDS_BYTES - LDSCTL_OFF) / 4; u += NWAVES * 64) ((LAS unsigned*)(F.lds + LDSCTL_OFF))[u] = 0u;
    __syncthreads();
    const int lo = args.ph_lo, hi = args.ph_hi;
    XcdBarrier bar; bar.bar = (unsigned*)(F.ctl + CW_BAR); bar.x = 0; bar.st = nullptr;
    if (hi - lo > 1) bar = xcd_barrier_post((unsigned*)(F.ctl + CW_BAR) + (size_t)lo * XCD_BAR_WORDS, F.MISC + 8);
    unsigned char* const ws = args.ws;
    const int gw = F.vcu * NWAVES + F.wave, NGW = F.G * NWAVES;
    LAS float* scr = (LAS float*)(F.lds + F.wave * 16640);

    if (IN(0)) {
        for (int it = F.vcu; it < 2 * 96; it += F.G) {
            const int l = it / 96, c0 = (it % 96) * 128 + 2 * F.lane;
            const float* W = args.in[4] + (size_t)l * D * MODW + c0;
            f32x2 a0 = {0.f, 0.f}, a1 = {0.f, 0.f}, a2 = {0.f, 0.f};
            for (int kc = 256 * F.wave; kc < 256 * F.wave + 256; kc += 64) {
                const float s0 = silu_f(args.in[1][kc + F.lane]), s1 = silu_f(args.in[1][D + kc + F.lane]), s2 = silu_f(args.in[3][kc + F.lane]);
#pragma unroll 16
                for (int kk = 0; kk < 64; ++kk) {
                    const f32x2 w = *(const f32x2*)(W + (size_t)(kc + kk) * MODW);
                    const float b0 = __builtin_bit_cast(float, __builtin_amdgcn_readlane(__builtin_bit_cast(int, s0), kk)), b1 = __builtin_bit_cast(float, __builtin_amdgcn_readlane(__builtin_bit_cast(int, s1), kk)), b2 = __builtin_bit_cast(float, __builtin_amdgcn_readlane(__builtin_bit_cast(int, s2), kk));
                    a0 += w * b0; a1 += w * b1; a2 += w * b2;
                }
            }
            LAS f32x2* red = (LAS f32x2*)F.lds;
            red[(F.wave * 3 + 0) * 64 + F.lane] = a0; red[(F.wave * 3 + 1) * 64 + F.lane] = a1; red[(F.wave * 3 + 2) * 64 + F.lane] = a2;
            LDS_WAIT(); __syncthreads();
            if (F.wave < 3) {
                f32x2 t = {0.f, 0.f};
#pragma unroll
                for (int w2 = 0; w2 < 8; ++w2) t += red[(w2 * 3 + F.wave) * 64 + F.lane];
                const f32x2 bb = *(const f32x2*)(args.in[5] + (size_t)l * MODW + c0);
                *(f32x2*)(MOD + ((size_t)l * 3 + F.wave) * MODW + c0) = t + bb;
            }
            LDS_WAIT(); __syncthreads();
        }
        const int gt = F.vcu * 512 + F.tid, NGT = F.G * 512;
        for (int i = gt; i < 192 * 64; i += NGT) {
            const int j = i & 63, rc = i >> 6;
            double fr = 1.0; for (int q = 0; q < j; ++q) fr *= 0.8659643233600653;
            const double ang = (double)(rc < 128 ? rc : rc - 128) * fr;
            float s, c; sincos_d(ang, s, c);
            float* dst = (rc < 128) ? ROPER + ((size_t)rc * 64 + j) * 2 : ROPEC + ((size_t)(rc - 128) * 64 + j) * 2;
            dst[0] = c; dst[1] = s;
        }
        if (gt < 16) { const float raw = (gt < 8) ? args.in[12][gt] : args.in[13][gt - 8];
            const float v = -log1pf(expf(-raw)) * 1.44269504088896341f; if (gt < 8) L2F[gt] = v; else L2B[gt - 8] = v; }
        for (int i = gt; i < 2 * D * NE; i += NGT) {
            const int l = i / (D * NE), r = i % (D * NE), k = r / NE, e = r % NE;
            const float w = args.in[16][i]; const unsigned whi = f2bf(w); const float wlo = w - bf2f(whi);
            RW[((size_t)(l * 2 + 0) * NE + e) * D + k] = (bf16)whi; RW[((size_t)(l * 2 + 1) * NE + e) * D + k] = (bf16)f2bf(wlo);
        }
        { JobP0 dec{args.in[10], args.in[11], args.in[14], WIN, WOUT, WPOOL}; conv_loop(dec, gw, NGW, JobP0::N, scr, F.lane); }
        if (CONV_P2 == 0 || F.G % 8 != 0 || CONV_P2 >= F.G / 8) { JobExp dec{args.in[18], args.in[19], args.in[20], args.in[21], args.in[22], args.in[23], (bf16*)(ws + WS_W13_0), (bf16*)(ws + WS_W2_0), 0, 2}; conv_loop(dec, gw, NGW, dec.count(), scr, F.lane); }
    }
    SEAM(0);

    if (IN(1)) {
        for (int r = gw; r < NTOK0; r += NGW) {
            const float* xr = (r < NLAT) ? args.in[0] + (size_t)r * D : args.in[2] + (size_t)(r - NLAT) * D;
            const int v = (r < NLAT) ? (r >> 13) : 2;
            const float* md = MOD + (size_t)v * MODW;
#pragma unroll
            for (int j = 0; j < 4; ++j) {
                const int c = j * 512 + F.lane * 8;
                const f32x4 x0 = *(const f32x4*)(xr + c), x1 = *(const f32x4*)(xr + c + 4);
                const f32x4 h0 = *(const f32x4*)(md + c), h1 = *(const f32x4*)(md + c + 4), s0 = *(const f32x4*)(md + D + c), s1 = *(const f32x4*)(md + D + c + 4);
                *(u32x4*)(HB + (size_t)r * D + c) = pack8(x0 * (s0 + 1.0f) + h0, x1 * (s1 + 1.0f) + h1);
            }
        }
    }
    SEAM(1);

    if (IN(2)) {
        const Roles R = make_roles(F, CONV_P2);
        if (!R.is_conv) {
            SchedWin S{(const char*)HB, (const char*)WIN, R.g_count, R.g_rank};
            EpiWin E{KR, KDTF, KDTB, PQ, VS, GS, ROPER, ROPEC, L2F, L2B};
            gemm_run<0>(F.lds, Dims{D, D, D}, S, E);
        } else {
            JobExp dec{args.in[18], args.in[19], args.in[20], args.in[21], args.in[22], args.in[23], (bf16*)(ws + WS_W13_0), (bf16*)(ws + WS_W2_0), 0, 2};
            conv_loop(dec, R.c_rank * NWAVES + F.wave, R.c_count * NWAVES, dec.count(), scr, F.lane);
        }
    }
    SEAM(2);

    if (IN(3)) {
        SchedRet3 S{(const char*)PQ, (const char*)KR, (const char*)VS, (const char*)KDTF, (size_t)(WS_KDTB - WS_KDTF), F.G, F.vcu};
        EpiRet3 E{PQ, UB, L2F, L2B};
        gemm_run<1>(F.lds, Dims{768, 256, 256}, S, E);
    }
    SEAM(3);

    if (IN(4)) {
        const int gt = F.vcu * 512 + F.tid, NGT = F.G * 512;
        for (int it = gt; it < 16 * 2 * 512 * 32; it += NGT) {
            const int dkc = it & 31, dv = (it >> 5) & 511, dir = (it >> 14) & 1, bh = it >> 15, b = bh >> 3, h = bh & 7;
            const float dec = exp2f((dir ? L2B[h] : L2F[h]) * 256.0f);
            float s[8];
#pragma unroll
            for (int j = 0; j < 8; ++j) s[j] = 0.f;
            for (int st = 0; st < 33; ++st) {
                const int pm = (st == 0) ? 64 + b : b * 32 + (dir ? 32 - st : st - 1);
                const size_t idx = (size_t)pm * 8 + h;
                u32x4 w; w.x = cvt_pk_bf16(s[0], s[1]); w.y = cvt_pk_bf16(s[2], s[3]); w.z = cvt_pk_bf16(s[4], s[5]); w.w = cvt_pk_bf16(s[6], s[7]);
                *(u32x4*)(VS + idx * VS_E + (size_t)dv * 768 + 256 + dir * 256 + dkc * 8) = w;
                if (st == 32) break;
                const u32x4 uv = *(const u32x4*)(UB + (idx * 2 + dir) * U_E + (size_t)dv * 256 + dkc * 8);
                s[0] = s[0] * dec + bf2f(uv.x & 0xffffu); s[1] = s[1] * dec + bf2f(uv.x >> 16);
                s[2] = s[2] * dec + bf2f(uv.y & 0xffffu); s[3] = s[3] * dec + bf2f(uv.y >> 16);
                s[4] = s[4] * dec + bf2f(uv.z & 0xffffu); s[5] = s[5] * dec + bf2f(uv.z >> 16);
                s[6] = s[6] * dec + bf2f(uv.w & 0xffffu); s[7] = s[7] * dec + bf2f(uv.w >> 16);
            }
        }
    }
    SEAM(4);

    if (IN(5)) {
        SchedO S{(const char*)PQ, (const char*)VS, F.G, F.vcu};
        EpiO E{OB};
        gemm_run<2>(F.lds, Dims{768, 768, 768}, S, E);
    }
    SEAM(5);

    if (IN(6)) {
        for (int it0 = gw; it0 < NLAT * NH; it0 += 4 * NGW) {
            u32x4 ov[4], gv[4]; size_t off[4];
#pragma unroll
            for (int q = 0; q < 4; ++q) { const int it = it0 + q * NGW;
                const int itc = it < NLAT * NH ? it : it0;
                off[q] = (size_t)(itc >> 3) * VD + (size_t)(itc & 7) * 512 + F.lane * 8;
                ov[q] = *(const u32x4*)(OB + off[q]); gv[q] = *(const u32x4*)(GS + off[q]); }
            u32x4 wq[4];
#pragma unroll
            for (int q = 0; q < 4; ++q) {
                float o[8], g[8];
                o[0] = bf2f(ov[q].x & 0xffffu); o[1] = bf2f(ov[q].x >> 16); o[2] = bf2f(ov[q].y & 0xffffu); o[3] = bf2f(ov[q].y >> 16);
                o[4] = bf2f(ov[q].z & 0xffffu); o[5] = bf2f(ov[q].z >> 16); o[6] = bf2f(ov[q].w & 0xffffu); o[7] = bf2f(ov[q].w >> 16);
                g[0] = bf2f(gv[q].x & 0xffffu); g[1] = bf2f(gv[q].x >> 16); g[2] = bf2f(gv[q].y & 0xffffu); g[3] = bf2f(gv[q].y >> 16);
                g[4] = bf2f(gv[q].z & 0xffffu); g[5] = bf2f(gv[q].z >> 16); g[6] = bf2f(gv[q].w & 0xffffu); g[7] = bf2f(gv[q].w >> 16);
#pragma unroll
                for (int j = 0; j < 8; ++j) g[j] = silu_f(g[j]);
                float sm = 0.f;
#pragma unroll
                for (int j = 0; j < 8; ++j) sm += o[j];
                const float mu = wave_sum(sm) * (1.0f / 512.0f);
                float sq = 0.f;
#pragma unroll
                for (int j = 0; j < 8; ++j) { o[j] -= mu; sq += o[j] * o[j]; }
                const float rstd = 1.0f / sqrtf(wave_sum(sq) * (1.0f / 512.0f) + LN_EPS);
                wq[q].x = cvt_pk_bf16(o[0] * rstd * g[0], o[1] * rstd * g[1]); wq[q].y = cvt_pk_bf16(o[2] * rstd * g[2], o[3] * rstd * g[3]);
                wq[q].z = cvt_pk_bf16(o[4] * rstd * g[4], o[5] * rstd * g[5]); wq[q].w = cvt_pk_bf16(o[6] * rstd * g[6], o[7] * rstd * g[7]);
            }
#pragma unroll
            for (int q = 0; q < 4; ++q) if (it0 + q * NGW < NLAT * NH) *(u32x4*)(A2 + off[q]) = wq[q];
        }
    }
    SEAM(6);

    if (IN(7)) {
        SchedDense S{(const char*)A2, (const char*)WOUT, VD, VD, 64, D / 256, 64 * (D / 256), F.G, (int)blockIdx.x};
        EpiResid E{R1, args.in[0], args.in[2], NLAT, MOD + 2 * D, nullptr, 0};
        gemm_run<3>(F.lds, Dims{VD, VD, VD}, S, E);
    }
    SEAM(7);

    layer_tail<0>(F, args, lo, hi, bar);
    layer_tail<1>(F, args, lo, hi, bar);
}

extern "C" void kernel_launch(void* const* d_in, const int* in_sizes, int n_in, void* d_out, int out_size, void* d_ws, size_t ws_size, hipStream_t stream) {
    static int grid = 0;
    if (grid == 0) {
        if (n_in != 24 || in_sizes[0] != NLAT * D || out_size != NLAT * D || ws_size < WS_END) {
            fprintf(stderr, "kernel_launch: unexpected problem (n_in %d, in0 %d, out %d, ws %zu; need ws >= %zu); nothing launched\n", n_in, n_in > 0 ? in_sizes[0] : -1, out_size, ws_size, (size_t)WS_END);
            grid = -1; return; }
        int dev = 0, cus = 0, per_cu = 0;
        if (hipGetDevice(&dev) != hipSuccess || hipDeviceGetAttribute(&cus, hipDeviceAttributeMultiprocessorCount, dev) != hipSuccess) { grid = -1; return; }
        if (hipFuncSetAttribute((const void*)mk_fwd, hipFuncAttributeMaxDynamicSharedMemorySize, LDS_BYTES) != hipSuccess) { fprintf(stderr, "kernel_launch: hipFuncSetAttribute failed\n"); grid = -1; return; }
        if (hipOccupancyMaxActiveBlocksPerMultiprocessor(&per_cu, (const void*)mk_fwd, NWAVES * 64, LDS_BYTES) != hipSuccess || per_cu < 1) {
            fprintf(stderr, "kernel_launch: occupancy query reports %d workgroups per CU\n", per_cu); }
        (void)hipGetLastError();
        grid = cus;
    }
    if (grid < 0) return;
    if (hipMemsetAsync((char*)d_ws + WS_CTL, 0, CTL_ZERO_BYTES, stream) != hipSuccess) { fprintf(stderr, "kernel_launch: memset failed\n"); return; }
    Args a{};
    for (int i = 0; i < 24; ++i) a.in[i] = (const float*)d_in[i];
    a.out = (float*)d_out; a.ws = (unsigned char*)d_ws;
#if MK_PER_PHASE
    for (int p = 0; p < PH_LIMIT; ++p) { a.ph_lo = p; a.ph_hi = p + 1; hipLaunchKernelGGL(mk_fwd, dim3(grid), dim3(NWAVES * 64), LDS_BYTES, stream, a); }
#else
    a.ph_lo = 0; a.ph_hi = NPH; hipLaunchKernelGGL(mk_fwd, dim3(grid), dim3(NWAVES * 64), LDS_BYTES, stream, a);
#endif
    const hipError_t le = hipPeekAtLastError();
    if (le != hipSuccess) fprintf(stderr, "kernel_launch: launch failed: %s\n", hipGetErrorName(le));
}
```

```cpp
#include <hip/hip_runtime.h>
#include <cstdio>
#include <cstdint>

#define GAS __attribute__((address_space(1)))
#define LAS __attribute__((address_space(3)))
typedef unsigned short bf16;
typedef short bf16x8 __attribute__((ext_vector_type(8)));
typedef float f32x4 __attribute__((ext_vector_type(4)));
typedef float f32x2 __attribute__((ext_vector_type(2)));
typedef unsigned u32x4 __attribute__((ext_vector_type(4)));
typedef unsigned u32x2 __attribute__((ext_vector_type(2)));

#ifndef MK_PER_PHASE
#define MK_PER_PHASE 0
#endif
#ifndef FAST_MASK
#define FAST_MASK 0x7f
#endif
#ifndef CONV_P2
#define CONV_P2 6
#endif
#ifndef CONV_P9
#define CONV_P9 4
#endif
#ifndef CONV_P10
#define CONV_P10 5
#endif
#ifndef CONV_P15
#define CONV_P15 1
#endif
#ifndef W2_LATE
#define W2_LATE 4096
#endif
#ifndef W13_SPLIT
#define W13_SPLIT 24000
#endif
#ifndef PH_LIMIT
#define PH_LIMIT 18
#endif

constexpr int D = 2048, NB = 2, SEQ = 8192, NLAT = NB * SEQ, CTXL = 256, NCTX = NB * CTXL, NTOK0 = NLAT + NCTX;
constexpr int NH = 8, DKH = 256, DVH = 512, VD = 4096, RIN = 12288;
constexpr int NE = 64, NE1 = 65, ED = 512;
constexpr int MODW = 6 * D;
constexpr float ALPHA = 1.41421356237309515f, LN_EPS = 1e-5f, ROUTED_SCALE = 2.5f;
constexpr int CAP = 16896;
constexpr int NPANEL0 = NTOK0 / 256;
constexpr int NIDX = NPANEL0 * NH;
constexpr int NQK = 64 * NH;
constexpr int NPH = 18;

constexpr size_t MiB = 1u << 20;
constexpr size_t WS_CTL = 0, CTL_ZERO_BYTES = 1 * MiB;
constexpr size_t WS_MOD = 1 * MiB;
constexpr size_t WS_ROPE = 1 * MiB + 512 * 1024;
constexpr size_t WS_L2G = WS_ROPE + 128 * 1024;
constexpr size_t WS_RW = 2 * MiB;
constexpr size_t WS_TOKE = 4 * MiB, WS_TOKP = 5 * MiB;
constexpr size_t WS_ROWL = 6 * MiB, WS_SLOTG = 11 * MiB;
constexpr size_t WS_WIN = 16 * MiB, WS_WOUT = 64 * MiB, WS_WPOOL = 80 * MiB;
constexpr size_t WS_W13_0 = 82 * MiB, WS_W2_0 = 342 * MiB;
constexpr size_t WS_HB = 472 * MiB, WS_XL = 538 * MiB, WS_R1 = 670 * MiB, WS_S = 802 * MiB;
constexpr size_t WS_KR = WS_S, WS_KDTF = WS_S + 66 * MiB, WS_KDTB = WS_S + 132 * MiB, WS_PQ = WS_S + 198 * MiB, WS_VS = WS_S + 396 * MiB;
constexpr size_t WS_U = WS_S + 792 * MiB, WS_GS = WS_S + 1056 * MiB, WS_O = WS_U, WS_A2 = WS_S;
constexpr size_t WS_W13_1 = WS_S, WS_W2_1 = WS_S + 260 * MiB, WS_ACT = WS_S + 390 * MiB, WS_Y = WS_S + 556 * MiB;
constexpr size_t WS_END = 2048 * MiB;
static_assert(WS_GS + 132 * MiB <= WS_END && WS_Y + 658 * MiB <= WS_END && WS_ACT + 166 * MiB <= WS_Y, "ws map");
constexpr size_t PQ_E = 256 * 768, VS_E = 512 * 768, KR_E = 256 * 256, U_E = 512 * 256;
constexpr size_t W13_E = 1024 * 2048, W2_E = 2048 * 512;
constexpr int CW_CNT = 8192;
constexpr int CW_BAR = 4096;

constexpr int RING_BYTES = 131072;
constexpr int SCR_BYTES = 8 * 16640;
constexpr int LDSCTL_OFF = 136 * 1024;
constexpr int LDS_BYTES = 147456;
static_assert(SCR_BYTES <= LDSCTL_OFF, "lds");
constexpr int NWAVES = 8;

#define RLX_AGENT __ATOMIC_RELAXED, __HIP_MEMORY_SCOPE_AGENT
#define LDS_WAIT() asm volatile("s_waitcnt lgkmcnt(0)" ::: "memory")
#define VM_WAIT() asm volatile("s_waitcnt vmcnt(0)" ::: "memory")

__device__ __forceinline__ unsigned cvt_pk_bf16(float lo, float hi) { unsigned r; asm volatile("v_cvt_pk_bf16_f32 %0, %1, %2" : "=v"(r) : "v"(lo), "v"(hi)); return r; }
__device__ __forceinline__ unsigned f2bf(float f) { unsigned u = __builtin_bit_cast(unsigned, f); return (u + 0x7fffu + ((u >> 16) & 1u)) >> 16; }
__device__ __forceinline__ float bf2f(unsigned b) { return __builtin_bit_cast(float, b << 16); }
__device__ __forceinline__ u32x4 pack8(f32x4 a, f32x4 b) { u32x4 w; w.x = cvt_pk_bf16(a[0], a[1]); w.y = cvt_pk_bf16(a[2], a[3]); w.z = cvt_pk_bf16(b[0], b[1]); w.w = cvt_pk_bf16(b[2], b[3]); return w; }
__device__ __forceinline__ float silu_f(float x) { return x * __builtin_amdgcn_rcpf(1.0f + __expf(-x)); }
__device__ __forceinline__ float wave_sum(float v) {
#pragma unroll
    for (int o = 1; o < 64; o <<= 1) v += __shfl_xor(v, o);
    return v;
}
__device__ __forceinline__ float wave_max(float v) {
#pragma unroll
    for (int o = 1; o < 64; o <<= 1) v = fmaxf(v, __shfl_xor(v, o));
    return v;
}

#define XB_TMO      128
#define XB_XCNT(j)  (256  + 64 * (j))
#define XB_XSUB(j)  (1280 + 64 * (j))
#define XB_XGEN(j)  (2304 + 64 * (j))
#define XB_TOP      3328
#define XB_TOPGEN   3392
#define XCD_BAR_WORDS 3456
#define XB_SPIN_CAP (1u << 18)
__device__ __forceinline__ unsigned xb_ld(unsigned* p)              { return __hip_atomic_load(p, __ATOMIC_RELAXED, __HIP_MEMORY_SCOPE_AGENT); }
__device__ __forceinline__ unsigned xb_add(unsigned* p, unsigned v) { return __hip_atomic_fetch_add(p, v, __ATOMIC_RELAXED, __HIP_MEMORY_SCOPE_AGENT); }
__device__ __forceinline__ unsigned xb_xcc_id() { return (unsigned)__builtin_amdgcn_s_getreg((3 << 11) | 20) & 0xFu; }
#define XB_SPIN(cond, bar) do { unsigned _sp = 0; while (cond) { __builtin_amdgcn_s_sleep(1); \
    if ((++_sp & 255u) == 0u) { if (xb_ld(&(bar)[XB_TMO])) break; if (_sp > XB_SPIN_CAP) { atomicAdd(&(bar)[XB_TMO], 1u); break; } } } } while (0)
struct XcdBarrier { unsigned* bar; unsigned x; volatile LAS unsigned* st; };
__device__ __forceinline__ XcdBarrier xcd_barrier_post(unsigned* bar, volatile LAS unsigned* st) {
    XcdBarrier b; b.bar = bar; b.x = xb_xcc_id(); b.st = st;
    if (threadIdx.x == 0) (void)xb_add(&bar[XB_XCNT(b.x)], 1u);
    return b;
}
__device__ __forceinline__ void xcd_barrier_complete(unsigned* bar, unsigned x, unsigned& nloc, unsigned& nx) {
    const unsigned G = gridDim.x * gridDim.y * gridDim.z;
    unsigned sum, cnt, mine, sp = 0u;
    for (;;) {
        sum = 0u; cnt = 0u; mine = 0u;
#pragma unroll
        for (unsigned j = 0; j < 16; ++j) { const unsigned c = xb_ld(&bar[XB_XCNT(j)]); sum += c; cnt += (c > 0u) ? 1u : 0u; mine = (j == x) ? c : mine; }
        if (sum == G) break;
        __builtin_amdgcn_s_sleep(1);
        if ((++sp & 255u) == 0u) { if (xb_ld(&bar[XB_TMO])) break; if (sp > XB_SPIN_CAP) { atomicAdd(&bar[XB_TMO], 1u); break; } }
    }
    nloc = mine > 0u ? mine : 1u; nx = cnt > 0u ? cnt : 1u;
}
__device__ __forceinline__ void xcd_barrier(const XcdBarrier& b) {
    asm volatile("s_waitcnt vmcnt(0)" ::: "memory");
    __syncthreads();
    if (threadIdx.x == 0) {
        unsigned* bar = b.bar;
        __builtin_amdgcn_s_waitcnt(0);
        unsigned nloc = b.st[0], nx = b.st[1];
        if (nloc == 0u) { xcd_barrier_complete(bar, b.x, nloc, nx); b.st[0] = nloc; b.st[1] = nx; }
        const unsigned old = xb_add(&bar[XB_XSUB(b.x)], 1u);
        const unsigned gen = old / nloc;
        if (old + 1u == (gen + 1u) * nloc) {
            __builtin_amdgcn_fence(__ATOMIC_RELEASE, "agent");
            asm volatile("s_waitcnt vmcnt(0)" ::: "memory");
            const unsigned og = xb_add(&bar[XB_TOP], 1u);
            const unsigned tg = og / nx;
            if (og + 1u == (tg + 1u) * nx) xb_add(&bar[XB_TOPGEN], 1u);
            else XB_SPIN(xb_ld(&bar[XB_TOPGEN]) == tg, bar);
            __builtin_amdgcn_fence(__ATOMIC_ACQUIRE, "agent");
            xb_add(&bar[XB_XGEN(b.x)], 1u);
            asm volatile("s_waitcnt vmcnt(0)" ::: "memory");
        } else {
            XB_SPIN(xb_ld(&bar[XB_XGEN(b.x)]) == gen, bar);
            __builtin_amdgcn_fence(__ATOMIC_ACQUIRE, "agent");
            asm volatile("s_waitcnt vmcnt(0)" ::: "memory");
        }
    }
    __syncthreads();
}

namespace pg8 {
constexpr int BM = 256, BK = 64, HALF = 128, HTB = HALF * BK * 2, STAGE_BYTES = 8 * HTB;
__host__ __device__ __forceinline__ int lds_byte(int r, int c) { const int st = (r >> 4) * 2 + (c >> 5), rr = r & 15, cc = c & 31, ob = rr * 64 + cc * 2; return st * 1024 + (ob ^ (((ob >> 9) & 1) << 5)); }
__host__ __device__ __forceinline__ void stage_rc(int b, int& R, int& C) { const int st = b / 1024, sb = b % 1024, swz = sb ^ (((sb >> 9) & 1) << 5); R = (st >> 1) * 16 + swz / 64; C = (st & 1) * 32 + (swz % 64) / 2; }
__host__ __device__ __forceinline__ int perm32(int rho) { const int n = rho >> 4, i = rho & 15; return 8 * (i >> 2) + 4 * n + (i & 3); }

struct Unit { const char* a; const char* b; int pm, pn, x0, x1; };
struct Dims { int lda, ldb, K; };

template <class Epi, class Sched, bool GATHER>
__device__ __forceinline__ void gemm_simple(const Dims g, const Sched& S, const Epi& E) {
    const int tid = threadIdx.x, wid = __builtin_amdgcn_readfirstlane(tid >> 6), lane = tid & 63, wr = wid >> 2, wc = wid & 3, fr = lane & 15, fq = lane >> 4;
    Unit u;
    for (int ui = 0; S.next(ui, u); ++ui) {
        f32x4 acc[2][2][4][2];
#pragma unroll
        for (int a = 0; a < 2; ++a)
#pragma unroll
            for (int b = 0; b < 2; ++b)
#pragma unroll
                for (int m = 0; m < 4; ++m)
#pragma unroll
                    for (int n = 0; n < 2; ++n) acc[a][b][m][n] = (f32x4){0.f, 0.f, 0.f, 0.f};
        unsigned aoff[2][4], boff[2][2];
#pragma unroll
        for (int ai = 0; ai < 2; ++ai)
#pragma unroll
            for (int m = 0; m < 4; ++m) { const int R = 128 * ai + 64 * wr + 16 * m + fr; const int row = GATHER ? S.row_of(u, R) : R; aoff[ai][m] = ((unsigned)row * (unsigned)g.lda + (unsigned)fq * 8u) * 2u; }
#pragma unroll
        for (int bj = 0; bj < 2; ++bj)
#pragma unroll
            for (int n = 0; n < 2; ++n) { const int R = 128 * bj + 32 * wc + (Epi::PERM ? perm32(16 * n + fr) : 16 * n + fr); boff[bj][n] = ((unsigned)R * (unsigned)g.ldb + (unsigned)fq * 8u) * 2u; }
        for (int k = 0; k < g.K; k += 32) {
#pragma unroll
            for (int ai = 0; ai < 2; ++ai) {
                bf16x8 At[4];
#pragma unroll
                for (int m = 0; m < 4; ++m) At[m] = *(const bf16x8*)(u.a + aoff[ai][m] + (size_t)k * 2);
#pragma unroll
                for (int bj = 0; bj < 2; ++bj) {
                    bf16x8 Bt[2];
#pragma unroll
                    for (int n = 0; n < 2; ++n) Bt[n] = *(const bf16x8*)(u.b + boff[bj][n] + (size_t)k * 2);
#pragma unroll
                    for (int m = 0; m < 4; ++m)
#pragma unroll
                        for (int n = 0; n < 2; ++n) acc[ai][bj][m][n] = __builtin_amdgcn_mfma_f32_16x16x32_bf16(Bt[n], At[m], acc[ai][bj][m][n], 0, 0, 0);
                    asm volatile("" ::: "memory");
                }
            }
        }
        __syncthreads();
        { int fr2 = fr, fq2 = fq, wr2 = wr, wc2 = wc; asm volatile("" : "+v"(fr2), "+v"(fq2), "+s"(wr2), "+s"(wc2)); E(acc, u, wr2, wc2, fr2, fq2); }
    }
}

template <class Epi, class Sched, bool GATHER>
__device__ __forceinline__ void gemm_fast(LAS unsigned char* lds, const Dims g, const Sched& S, const Epi& E) {
    const int tid = threadIdx.x, wid = __builtin_amdgcn_readfirstlane(tid >> 6), lane = tid & 63, wr = wid >> 2, wc = wid & 3, fr = lane & 15, fq = lane >> 4;
    const int nt = g.K / BK;
    unsigned voffA[2][2], voffB[2];
#pragma unroll
    for (int i = 0; i < 2; ++i) { int R, C; stage_rc(tid * 16 + i * 8192, R, C); const int Rb = Epi::PERM ? ((R & ~31) + perm32(R & 31)) : R;
        voffA[0][i] = (unsigned)(R * g.lda + C) * 2u; voffA[1][i] = (unsigned)((R + HALF) * g.lda + C) * 2u; voffB[i] = (unsigned)(Rb * g.ldb + C) * 2u; }
    const size_t kstep = (size_t)(BK * 2);
    const size_t hstepB = (size_t)HALF * g.ldb * 2;
    const unsigned ldsw = (unsigned)wid * 1024u;
    const int aoff = lds_byte(wr * 64 + fr, fq * 8), boff = lds_byte(wc * 32 + fr, fq * 8);
#define PG8_SA(b, h) (((b) * 2 + (h)) * HTB)
#define PG8_SB(b, h) ((4 + (b) * 2 + (h)) * HTB)
#define PG8_STAGEA(bufoff, gbase, h) do { _Pragma("unroll") for (int _i = 0; _i < 2; ++_i) \
        __builtin_amdgcn_global_load_lds((const unsigned*)((const char*)(gbase) + voffA[h][_i]), (LAS unsigned*)(lds + (bufoff) + ldsw + _i * 8192), 16, 0, 0); } while (0)
#define PG8_STAGEB(bufoff, gbase) do { _Pragma("unroll") for (int _i = 0; _i < 2; ++_i) \
        __builtin_amdgcn_global_load_lds((const unsigned*)((const char*)(gbase) + voffB[_i]), (LAS unsigned*)(lds + (bufoff) + ldsw + _i * 8192), 16, 0, 0); } while (0)
#define PG8_LDA(dst, b, h) do { _Pragma("unroll") for (int m = 0; m < 4; ++m) _Pragma("unroll") for (int k = 0; k < 2; ++k) dst[m][k] = *(const LAS bf16x8*)(lds + PG8_SA(b, h) + aoff + m * 2048 + k * 1024); } while (0)
#define PG8_LDB(dst, b, h) do { _Pragma("unroll") for (int n = 0; n < 2; ++n) _Pragma("unroll") for (int k = 0; k < 2; ++k) dst[n][k] = *(const LAS bf16x8*)(lds + PG8_SB(b, h) + boff + n * 2048 + k * 1024); } while (0)
#define PG8_MMA(ai, bj, At, Bt) do { __builtin_amdgcn_s_setprio(1); _Pragma("unroll") for (int m = 0; m < 4; ++m) _Pragma("unroll") for (int n = 0; n < 2; ++n) _Pragma("unroll") for (int k = 0; k < 2; ++k) \
        acc[ai][bj][m][n] = __builtin_amdgcn_mfma_f32_16x16x32_bf16(Bt[n][k], At[m][k], acc[ai][bj][m][n], 0, 0, 0); __builtin_amdgcn_s_setprio(0); } while (0)
#define PG8_WAIT_V(n) asm volatile("s_waitcnt vmcnt(" #n ")" ::: "memory")
#define PG8_WAIT_L(n) asm volatile("s_waitcnt lgkmcnt(" #n ")" ::: "memory")
#define PG8_BAR __builtin_amdgcn_s_barrier()
#define PG8_SCHED __builtin_amdgcn_sched_barrier(0)
#define PG8_GOFF(uu) do { if constexpr (GATHER) { _Pragma("unroll") for (int _i = 0; _i < 2; ++_i) { int _R, _C; stage_rc((int)threadIdx.x * 16 + _i * 8192, _R, _C); _Pragma("unroll") for (int _h = 0; _h < 2; ++_h) \
        voffA[_h][_i] = ((unsigned)S.row_of(uu, _R + _h * HALF) * (unsigned)g.lda + (unsigned)_C) * 2u; } } } while (0)
    Unit cur, nxt; int ui = 0;
    if (!S.next(0, cur)) return;
    f32x4 acc[2][2][4][2];
#pragma unroll
    for (int a = 0; a < 2; ++a)
#pragma unroll
        for (int b = 0; b < 2; ++b)
#pragma unroll
            for (int m = 0; m < 4; ++m)
#pragma unroll
                for (int n = 0; n < 2; ++n) acc[a][b][m][n] = (f32x4){0.f, 0.f, 0.f, 0.f};
    bf16x8 At[4][2], B0[2][2], B1[2][2];
    const char* cA = cur.a; const char* cB = cur.b;
    PG8_GOFF(cur);
    PG8_STAGEB(PG8_SB(0, 0), cB); PG8_STAGEB(PG8_SB(0, 1), cB + hstepB); PG8_STAGEA(PG8_SA(0, 0), cA, 0); PG8_STAGEA(PG8_SA(0, 1), cA, 1);
    if (wr == 1) PG8_BAR;
    PG8_WAIT_V(2); PG8_BAR;
    PG8_STAGEB(PG8_SB(1, 0), cB + kstep); PG8_STAGEA(PG8_SA(1, 0), cA + kstep, 0); PG8_STAGEB(PG8_SB(1, 1), cB + hstepB + kstep);
    PG8_WAIT_V(6); PG8_BAR;
    for (;;) {
        const bool has_next = S.next(ui + 1, nxt);
        const char* nA = has_next ? nxt.a : cA; const char* nB = has_next ? nxt.b : cB;
        for (int t = 0; t < nt; t += 2) {
            const bool last = (t == nt - 2);
            const char* a1 = cA + (size_t)(t + 1) * kstep;
            const char* a2 = last ? nA : cA + (size_t)(t + 2) * kstep; const char* b2 = last ? nB : cB + (size_t)(t + 2) * kstep;
            const char* a3 = a2 + kstep; const char* b3 = b2 + kstep;
            PG8_LDB(B0, 0, 0); PG8_LDB(B1, 0, 1); PG8_SCHED; PG8_LDA(At, 0, 0); PG8_STAGEA(PG8_SA(1, 1), a1, 1);
            if (last && has_next) PG8_GOFF(nxt);
            PG8_WAIT_V(8); PG8_WAIT_L(0); PG8_BAR; PG8_MMA(0, 0, At, B0); PG8_MMA(0, 1, At, B1); PG8_BAR; PG8_SCHED;
            PG8_LDA(At, 0, 1); PG8_STAGEB(PG8_SB(0, 0), b2); PG8_STAGEB(PG8_SB(0, 1), b2 + hstepB); PG8_STAGEA(PG8_SA(0, 0), a2, 0);
            PG8_WAIT_V(8); PG8_WAIT_L(0); PG8_BAR; PG8_MMA(1, 0, At, B0); PG8_MMA(1, 1, At, B1); PG8_BAR; PG8_SCHED;
            PG8_LDB(B0, 1, 0); PG8_LDB(B1, 1, 1); PG8_SCHED; PG8_LDA(At, 1, 0); PG8_STAGEA(PG8_SA(0, 1), a2, 1);
            PG8_WAIT_V(8); PG8_WAIT_L(0); PG8_BAR; PG8_MMA(0, 0, At, B0); PG8_MMA(0, 1, At, B1); PG8_BAR; PG8_SCHED;
            PG8_LDA(At, 1, 1); PG8_STAGEB(PG8_SB(1, 0), b3); PG8_STAGEB(PG8_SB(1, 1), b3 + hstepB); PG8_STAGEA(PG8_SA(1, 0), a3, 0);
            PG8_WAIT_V(8); PG8_WAIT_L(0); PG8_BAR; PG8_MMA(1, 0, At, B0); PG8_MMA(1, 1, At, B1); PG8_BAR; PG8_SCHED;
        }
        if (wr == 0) PG8_BAR;
        { int fr2 = fr, fq2 = fq, wr2 = wr, wc2 = wc; asm volatile("" : "+v"(fr2), "+v"(fq2), "+s"(wr2), "+s"(wc2)); E(acc, cur, wr2, wc2, fr2, fq2); }
        if (!has_next) break;
#pragma unroll
        for (int a = 0; a < 2; ++a)
#pragma unroll
            for (int b = 0; b < 2; ++b)
#pragma unroll
                for (int m = 0; m < 4; ++m)
#pragma unroll
                    for (int n = 0; n < 2; ++n) acc[a][b][m][n] = (f32x4){0.f, 0.f, 0.f, 0.f};
        cur = nxt; cA = nA; cB = nB; ++ui;
        if (wr == 1) PG8_BAR;
    }
    PG8_WAIT_V(0);
    PG8_BAR;
#undef PG8_SA
#undef PG8_SB
#undef PG8_STAGEA
#undef PG8_STAGEB
#undef PG8_LDA
#undef PG8_LDB
#undef PG8_MMA
#undef PG8_WAIT_V
#undef PG8_WAIT_L
#undef PG8_BAR
#undef PG8_SCHED
#undef PG8_GOFF
}
}
using pg8::Unit;
using pg8::Dims;

template <int SITE, class Epi, class Sched, bool GATHER = false>
__device__ __forceinline__ void gemm_run(LAS unsigned char* lds, const Dims g, const Sched& S, const Epi& E) {
    if constexpr (((FAST_MASK) >> SITE) & 1) pg8::gemm_fast<Epi, Sched, GATHER>(lds, g, S, E);
    else pg8::gemm_simple<Epi, Sched, GATHER>(g, S, E);
}

struct Frame {
    LAS unsigned char* lds;
    volatile LAS unsigned* MISC;
    LAS int* TAB;
    unsigned* ctl;
    unsigned char* ws;
    int tid, lane, wave, vcu, G;
    float* out;
};
constexpr int NXCD = 8, WGM = 8;

struct SchedDense {
    const char* A; const char* Bt; int lda, ldb, nM, nN, nwg, G, c;
    __device__ __forceinline__ bool next(int i, Unit& u) const {
        const long L = (long)i * G + c; if (L >= nwg) return false;
        int wgid = (int)L; { const int q = nwg / NXCD, r = nwg % NXCD, xcd = wgid % NXCD, off = wgid / NXCD; wgid = (xcd < r ? xcd * (q + 1) : r * (q + 1) + (xcd - r) * q) + off; }
        const int nig = WGM * nN, gid = wgid / nig, fm = gid * WGM, gsz = (nM - fm) < WGM ? (nM - fm) : WGM;
        u.pm = fm + ((wgid % nig) % gsz); u.pn = (wgid % nig) / gsz; u.x0 = 0; u.x1 = 0;
        u.a = A + (size_t)u.pm * 256 * lda * 2; u.b = Bt + (size_t)u.pn * 256 * ldb * 2; return true;
    }
    __device__ __forceinline__ int row_of(const Unit&, int R) const { return R; }
};
struct SchedRet3 {
    const char* PQ; const char* KR; const char* VS; const char* KDT; size_t kdt_dir_stride; int G, vcu;
    __device__ __forceinline__ bool next(int i, Unit& u) const {
        const int L = i * G + vcu; if (L >= NQK + 2048) return false;
        if (L < NQK) { u.pm = L; u.x0 = 0; u.x1 = 0; u.pn = 0; u.a = PQ + ((size_t)L * PQ_E + 256) * 2; u.b = KR + (size_t)L * KR_E * 2; }
        else { const int j = L - NQK; int panel, h, dir; const int half = j & 1;
            if (j < 1984) { const int pq = j >> 5; h = (j >> 2) & 7; dir = (j >> 1) & 1; panel = pq < 60 ? (pq >= 30 ? 3 : 1) + pq : 4 + pq; }
            else { const int k = j - 1984, w = k >> 4; h = (k >> 1) & 7; dir = w & 1; panel = (w >> 1) * 32 + (w & 1) * 31; }
            const int idx = panel * 8 + h; u.pm = idx; u.x0 = 1; u.x1 = dir * 2 + half; u.pn = 0;
            u.a = VS + ((size_t)idx * VS_E + (size_t)half * 256 * 768) * 2; u.b = KDT + (size_t)dir * kdt_dir_stride + (size_t)idx * KR_E * 2; }
        return true;
    }
    __device__ __forceinline__ int row_of(const Unit&, int R) const { return R; }
};
struct SchedO {
    const char* PQ; const char* VS; int G, vcu;
    __device__ __forceinline__ bool next(int i, Unit& u) const {
        const int L = i * G + vcu; if (L >= NQK * 2) return false;
        const int idx = L >> 1, half = L & 1; u.pm = idx; u.pn = half; u.x0 = 0; u.x1 = 0;
        u.a = PQ + (size_t)idx * PQ_E * 2; u.b = VS + ((size_t)idx * VS_E + (size_t)half * 256 * 768) * 2; return true;
    }
    __device__ __forceinline__ int row_of(const Unit&, int R) const { return R; }
};
struct SchedPool {
    const char* P; const char* W; int G, vcu;
    __device__ __forceinline__ bool next(int i, Unit& u) const {
        const int L = i * G + vcu; if (L >= 64 * 8) return false;
        const int pm = L >> 3, g = (L >> 1) & 3, half = L & 1; u.pm = pm; u.pn = g * 512 + half * 256; u.x0 = 0; u.x1 = 0;
        u.a = P + ((size_t)pm * 256 * D + (size_t)g * 512) * 2; u.b = W + ((size_t)g * 512 + (size_t)half * 256) * 512 * 2; return true;
    }
    __device__ __forceinline__ int row_of(const Unit&, int R) const { return R; }
};
struct SchedMoE {
    const LAS int* TAB; const char* A; const char* W; const int* rowl; int NT  , lda_bytes_per_row, G, vcu, gather; size_t wstride  , wtile  ;
    __device__ __forceinline__ bool next(int i, Unit& u) const {
        const int L = i * G + vcu; const int total = TAB[65];
        if (L >= total * NT) return false;
        const int pg = L / NT, pn = L - pg * NT;
        const int lane = threadIdx.x & 63;
        const int t1 = TAB[lane + 1];
        const int e = __builtin_popcountll(__ballot(t1 <= pg));
        const int panel = pg - TAB[e];
        u.pm = pg * 256; u.pn = pn; u.x0 = e; u.x1 = panel * 256;
        u.a = gather ? A : A + (size_t)pg * 256 * lda_bytes_per_row;
        u.b = W + (size_t)e * wstride + (size_t)pn * wtile; return true;
    }
    __device__ __forceinline__ int row_of(const Unit& u, int R) const {
        const int s = u.x1 + R;
        if (u.x0 == NE) return s;
        return (s < TAB[66 + u.x0]) ? rowl[(size_t)u.x0 * CAP + s] : 0;
    }
    __device__ __forceinline__ const int* row_ptr(const Unit& u, int R) const { const int e = u.x0 < NE ? u.x0 : 0; return rowl + (size_t)e * CAP + (u.x1 + R); }
    __device__ __forceinline__ int row_fix(const Unit& u, int R, int loaded) const {
        const int s = u.x1 + R;
        if (u.x0 == NE) return s;
        return (s < TAB[66 + u.x0]) ? loaded : 0;
    }
};


struct SchedWin {
    const char* HBp; const char* W; int G, vcu;
    __device__ __forceinline__ bool next(int i, Unit& u) const {
        const int L = i * G + vcu; if (L >= 2064 + 1056) return false;
        if (L < 2064) {
            int pm, pn;
            if (L < 2048) { const int gid = L >> 8, r = L & 255, t32 = r >> 3; pm = gid * 8 + (r & 7); pn = t32 < 16 ? t32 : t32 + 16; }
            else { const int j = L - 2048; pm = 64 + (j >> 3); pn = 8 + (j & 7); }
            u.pm = pm; u.pn = pn; u.x0 = 0; u.x1 = 0;
            u.a = HBp + (size_t)pm * 256 * D * 2; u.b = W + (size_t)pn * 256 * D * 2;
        } else {
            const int j = L - 2064, pm = j >> 4, rt = j & 15;
            u.pm = pm; u.pn = rt; u.x0 = 1; u.x1 = 0;
            u.a = W + (size_t)(4096 + 256 * rt) * D * 2; u.b = HBp + (size_t)pm * 256 * D * 2;
        }
        return true;
    }
    __device__ __forceinline__ int row_of(const Unit&, int R) const { return R; }
};
struct EpiWin {
    static constexpr bool PERM = true;
    bf16 *Kr, *Kdtf, *Kdtb, *PQ, *VS, *Gs; const float *ropeR, *ropeC, *l2f, *l2b;
    __device__ __forceinline__ void operator()(const f32x4 (&acc)[2][2][4][2], const Unit& u, int wr, int wc, int fr, int fq) const {
        const int pm = u.pm, pn = u.pn;
        if (u.x0 == 1) {
            const int h = pn >> 1, half = pn & 1, idx = pm * 8 + h;
#pragma unroll
            for (int ai = 0; ai < 2; ++ai)
#pragma unroll
                for (int m = 0; m < 4; ++m) {
                    const int dv = half * 256 + 128 * ai + 64 * wr + 16 * m + fr;
#pragma unroll
                    for (int bj = 0; bj < 2; ++bj)
                        *(u32x4*)(VS + (size_t)idx * VS_E + (size_t)dv * 768 + 128 * bj + 32 * wc + 8 * fq) = pack8(acc[ai][bj][m][0], acc[ai][bj][m][1]);
                }
            return;
        }
        if (pn < 16) {
            const int h = pn & 7; const bool isK = pn >= 8; const int idx = pm * 8 + h;
            const bool lat = pm < 64; const int pos0 = (pm & 31) * 256;
            const float lf = l2f[h], lb = l2b[h];
            const int i0 = 16 * wc + 4 * fq;
            f32x4 cR[2][2], cC[4][2];
#pragma unroll
            for (int ai = 0; ai < 2; ++ai) { const float* tab = ropeR + (size_t)((pos0 >> 6) + 2 * ai + wr) * 128 + 2 * i0; cR[ai][0] = *(const f32x4*)(tab); cR[ai][1] = *(const f32x4*)(tab + 4); }
#pragma unroll
            for (int m = 0; m < 4; ++m) { const float* tab = ropeC + (size_t)(16 * m + fr) * 128 + 2 * i0; cC[m][0] = *(const f32x4*)(tab); cC[m][1] = *(const f32x4*)(tab + 4); }
#pragma unroll
            for (int ai = 0; ai < 2; ++ai)
#pragma unroll
                for (int m = 0; m < 4; ++m) {
                    const int p = 128 * ai + 64 * wr + 16 * m + fr;
                    const float d1 = isK ? __builtin_amdgcn_exp2f(lf * (float)(255 - p)) * 0.0625f : __builtin_amdgcn_exp2f(lf * (float)(p + 1));
                    const float d2 = isK ? __builtin_amdgcn_exp2f(lb * (float)p) * 0.0625f : __builtin_amdgcn_exp2f(lb * (float)(256 - p));
#pragma unroll
                    for (int bj = 0; bj < 2; ++bj) {
                        const int dk0 = 128 * bj + 32 * wc + 8 * fq;
                        f32x4 v0 = acc[ai][bj][m][0], v1 = acc[ai][bj][m][1];
                        if (lat) {
                            const f32x4 c0 = (bj == 0) ? cR[ai][0] : cC[m][0], c1 = (bj == 0) ? cR[ai][1] : cC[m][1];
                            f32x4 r0, r1;
                            r0[0] = v0[0] * c0[0] - v0[1] * c0[1]; r0[1] = v0[0] * c0[1] + v0[1] * c0[0];
                            r0[2] = v0[2] * c0[2] - v0[3] * c0[3]; r0[3] = v0[2] * c0[3] + v0[3] * c0[2];
                            r1[0] = v1[0] * c1[0] - v1[1] * c1[1]; r1[1] = v1[0] * c1[1] + v1[1] * c1[0];
                            r1[2] = v1[2] * c1[2] - v1[3] * c1[3]; r1[3] = v1[2] * c1[3] + v1[3] * c1[2];
                            v0 = r0; v1 = r1;
                        }
                        if (!isK) {
                            bf16* row = PQ + (size_t)idx * PQ_E + (size_t)p * 768 + dk0;
                            *(u32x4*)(row + 256) = pack8(v0 * d1, v1 * d1);
                            *(u32x4*)(row + 512) = pack8(v0 * d2, v1 * d2);
                        } else {
                            *(u32x4*)(Kr + (size_t)idx * KR_E + (size_t)p * 256 + dk0) = pack8(v0 * 0.0625f, v1 * 0.0625f);
                            bf16* tf = Kdtf + (size_t)idx * KR_E + (size_t)dk0 * 256 + p;
                            bf16* tb = Kdtb + (size_t)idx * KR_E + (size_t)dk0 * 256 + p;
#pragma unroll
                            for (int j = 0; j < 4; ++j) {
                                const unsigned pf = cvt_pk_bf16(v0[j] * d1, v1[j] * d1), pb = cvt_pk_bf16(v0[j] * d2, v1[j] * d2);
                                tf[(size_t)j * 256] = (bf16)(pf & 0xffffu); tf[(size_t)(4 + j) * 256] = (bf16)(pf >> 16);
                                tb[(size_t)j * 256] = (bf16)(pb & 0xffffu); tb[(size_t)(4 + j) * 256] = (bf16)(pb >> 16);
                            }
                        }
                    }
                }
        } else {
            const int gc0 = (pn - 32) * 256;
#pragma unroll
            for (int ai = 0; ai < 2; ++ai)
#pragma unroll
                for (int m = 0; m < 4; ++m) {
                    const int r = 256 * pm + 128 * ai + 64 * wr + 16 * m + fr;
#pragma unroll
                    for (int bj = 0; bj < 2; ++bj) {
                        const int c = gc0 + 128 * bj + 32 * wc + 8 * fq;
                        f32x4 v0 = acc[ai][bj][m][0], v1 = acc[ai][bj][m][1];
                        *(u32x4*)(Gs + (size_t)r * VD + c) = pack8(v0, v1);
                        asm volatile("" ::: "memory");
                    }
                }
        }
    }
};
struct EpiRet3 {
    static constexpr bool PERM = true;
    bf16 *PQ, *U; const float *l2f, *l2b;
    __device__ __forceinline__ void operator()(const f32x4 (&acc)[2][2][4][2], const Unit& u, int wr, int wc, int fr, int fq) const {
        const int idx = u.pm;
        if (u.x0 == 0) {
            const int h = idx & 7; const float lf = l2f[h], lb = l2b[h];
#pragma unroll
            for (int ai = 0; ai < 2; ++ai)
#pragma unroll
                for (int m = 0; m < 4; ++m) {
                    const int p = 128 * ai + 64 * wr + 16 * m + fr;
#pragma unroll
                    for (int bj = 0; bj < 2; ++bj) {
                        const int c0 = 128 * bj + 32 * wc + 8 * fq;
                        u32x4 w;
#pragma unroll
                        for (int n = 0; n < 2; ++n) {
                            f32x4 v = acc[ai][bj][m][n];
#pragma unroll
                            for (int j = 0; j < 4; ++j) { const int cc = c0 + 4 * n + j, d = p - cc;
                                v[j] *= __builtin_amdgcn_exp2f(d >= 0 ? -lf * (float)(cc + 1) : lb * (float)(-d) - lf * (float)(p + 1)); }
                            const unsigned q0 = cvt_pk_bf16(v[0], v[1]), q1 = cvt_pk_bf16(v[2], v[3]);
                            if (n == 0) { w.x = q0; w.y = q1; } else { w.z = q0; w.w = q1; }
                        }
                        *(u32x4*)(PQ + (size_t)idx * PQ_E + (size_t)p * 768 + c0) = w;
                        asm volatile("" ::: "memory");
                    }
                }
        } else {
            const int dir = u.x1 >> 1, half = u.x1 & 1;
            bf16* base = U + ((size_t)idx * 2 + dir) * U_E;
#pragma unroll
            for (int ai = 0; ai < 2; ++ai)
#pragma unroll
                for (int m = 0; m < 4; ++m) {
                    const int dv = half * 256 + 128 * ai + 64 * wr + 16 * m + fr;
#pragma unroll
                    for (int bj = 0; bj < 2; ++bj) {
                        const int c0 = 128 * bj + 32 * wc + 8 * fq;
                        *(u32x4*)(base + (size_t)dv * 256 + c0) = pack8(acc[ai][bj][m][0], acc[ai][bj][m][1]);
                        asm volatile("" ::: "memory");
                    }
                }
        }
    }
};
struct EpiO {
    static constexpr bool PERM = true;
    bf16* O;
    __device__ __forceinline__ void operator()(const f32x4 (&acc)[2][2][4][2], const Unit& u, int wr, int wc, int fr, int fq) const {
        const int pm = u.pm >> 3, h = u.pm & 7, cb = h * 512 + u.pn * 256;
#pragma unroll
        for (int ai = 0; ai < 2; ++ai)
#pragma unroll
            for (int m = 0; m < 4; ++m) {
                const int r = 256 * pm + 128 * ai + 64 * wr + 16 * m + fr;
#pragma unroll
                for (int bj = 0; bj < 2; ++bj)
                    *(u32x4*)(O + (size_t)r * VD + cb + 128 * bj + 32 * wc + 8 * fq) = pack8(acc[ai][bj][m][0], acc[ai][bj][m][1]);
            }
    }
};
struct EpiResid {
    static constexpr bool PERM = false;
    float* R1; const float* xa; const float* xb; int nsplit; const float* gate; const float* cscale; int has_scale;
    __device__ __forceinline__ void operator()(const f32x4 (&acc)[2][2][4][2], const Unit& u, int wr, int wc, int fr, int fq) const {
        const int cb = u.pn * (has_scale ? 1 : 256);
        const int r0 = 256 * u.pm;
        const int v = (r0 < NLAT) ? (r0 >> 13) : 2;
        const float* gr = gate + (size_t)v * MODW;
        f32x4 gv[2][2];
#pragma unroll
        for (int bj = 0; bj < 2; ++bj)
#pragma unroll
            for (int n = 0; n < 2; ++n) { const int c = cb + 128 * bj + 32 * wc + 16 * n + 4 * fq; gv[bj][n] = *(const f32x4*)(gr + c); if (has_scale) gv[bj][n] = gv[bj][n] * *(const f32x4*)(cscale + c); }
#pragma unroll
        for (int ai = 0; ai < 2; ++ai) {
            f32x4 xv[4][2][2];
#pragma unroll
            for (int m = 0; m < 4; ++m) {
                const int r = r0 + 128 * ai + 64 * wr + 16 * m + fr;
                const float* xr = (r < nsplit) ? xa + (size_t)r * D : xb + (size_t)(r - nsplit) * D;
#pragma unroll
                for (int bj = 0; bj < 2; ++bj)
#pragma unroll
                    for (int n = 0; n < 2; ++n) xv[m][bj][n] = *(const f32x4*)(xr + cb + 128 * bj + 32 * wc + 16 * n + 4 * fq);
            }
#pragma unroll
            for (int m = 0; m < 4; ++m) {
                const int r = r0 + 128 * ai + 64 * wr + 16 * m + fr;
#pragma unroll
                for (int bj = 0; bj < 2; ++bj)
#pragma unroll
                    for (int n = 0; n < 2; ++n) *(f32x4*)(R1 + (size_t)r * D + cb + 128 * bj + 32 * wc + 16 * n + 4 * fq) = xv[m][bj][n] * ALPHA + gv[bj][n] * acc[ai][bj][m][n];
            }
        }
    }
};
struct EpiMoe1 {
    static constexpr bool PERM = true;
    bf16* ACT;
    __device__ __forceinline__ void operator()(const f32x4 (&acc)[2][2][4][2], const Unit& u, int wr, int wc, int fr, int fq) const {
#pragma unroll
        for (int ai = 0; ai < 2; ++ai)
#pragma unroll
            for (int m = 0; m < 4; ++m) {
                const int r = u.pm + 128 * ai + 64 * wr + 16 * m + fr;
                f32x4 v0, v1;
#pragma unroll
                for (int j = 0; j < 4; ++j) { v0[j] = silu_f(acc[ai][0][m][0][j]) * acc[ai][1][m][0][j]; v1[j] = silu_f(acc[ai][0][m][1][j]) * acc[ai][1][m][1][j]; }
                *(u32x4*)(ACT + (size_t)r * ED + u.pn * 128 + 32 * wc + 8 * fq) = pack8(v0, v1);
            }
    }
};
constexpr float Y_SCALE = 64.0f;
struct EpiMoe2 {
    static constexpr bool PERM = true;
    unsigned char* Y;
    __device__ __forceinline__ void operator()(const f32x4 (&acc)[2][2][4][2], const Unit& u, int wr, int wc, int fr, int fq) const {
#pragma unroll
        for (int ai = 0; ai < 2; ++ai)
#pragma unroll
            for (int m = 0; m < 4; ++m) {
                const int p = 128 * ai + 64 * wr + 16 * m + fr;
#pragma unroll
                for (int bj = 0; bj < 2; ++bj) {
                    f32x4 v0 = acc[ai][bj][m][0], v1 = acc[ai][bj][m][1];
#pragma unroll
                    for (int j = 0; j < 4; ++j) { v0[j] = __builtin_amdgcn_fmed3f(v0[j], -448.0f, 448.0f); v1[j] = __builtin_amdgcn_fmed3f(v1[j], -448.0f, 448.0f); }
                    int w0 = 0, w1 = 0;
                    w0 = __builtin_amdgcn_cvt_pk_fp8_f32(v0[0], v0[1], w0, false); w0 = __builtin_amdgcn_cvt_pk_fp8_f32(v0[2], v0[3], w0, true);
                    w1 = __builtin_amdgcn_cvt_pk_fp8_f32(v1[0], v1[1], w1, false); w1 = __builtin_amdgcn_cvt_pk_fp8_f32(v1[2], v1[3], w1, true);
                    u32x2 w; w.x = (unsigned)w0; w.y = (unsigned)w1;
                    *(u32x2*)(Y + (size_t)(u.pm + p) * D + 256 * u.pn + 128 * bj + 32 * wc + 8 * fq) = w;
                }
            }
    }
};

struct ConvJob { const float* src; bf16* dst; int ldw, ldt; float scale; };
__device__ __forceinline__ void conv_load(const ConvJob& j, f32x4 (&v)[16], int lane) {
    const float* src = j.src + (size_t)(lane >> 4) * j.ldw + (lane & 15) * 4;
#pragma unroll
    for (int i = 0; i < 16; ++i) v[i] = *(const f32x4*)(src + (size_t)(4 * i) * j.ldw);
}
__device__ __forceinline__ void conv_store(const ConvJob& j, const f32x4 (&v)[16], LAS float* scr, int lane) {
#pragma unroll
    for (int i = 0; i < 16; ++i) { LAS float* s = scr + (4 * i + (lane >> 4)) * 65 + (lane & 15) * 4; s[0] = v[i][0]; s[1] = v[i][1]; s[2] = v[i][2]; s[3] = v[i][3]; }
    LDS_WAIT(); asm volatile("" ::: "memory");
    const int c = lane & 7;
#pragma unroll
    for (int q = 0; q < 8; ++q) {
        const int n = (lane >> 3) + 8 * q; const LAS float* s = scr + (8 * c) * 65 + n;
        const float sc_ = j.scale;
        u32x4 o; o.x = cvt_pk_bf16(s[0 * 65] * sc_, s[1 * 65] * sc_); o.y = cvt_pk_bf16(s[2 * 65] * sc_, s[3 * 65] * sc_); o.z = cvt_pk_bf16(s[4 * 65] * sc_, s[5 * 65] * sc_); o.w = cvt_pk_bf16(s[6 * 65] * sc_, s[7 * 65] * sc_);
        *(u32x4*)(j.dst + (size_t)n * j.ldt + 8 * c) = o;
    }
    LDS_WAIT(); asm volatile("" ::: "memory");
}
struct JobP0 {
    const float *win, *wout, *wpool; bf16 *WINd, *WOUTd, *WPOOLd;
    static constexpr int N = 32 * 192 + 64 * 32 + 4 * 64;
    __device__ __forceinline__ ConvJob operator()(int r) const {
        ConvJob j; j.scale = 1.0f;
        if (r < 32 * 192) { const int kb = r / 192, nb = r % 192; j.src = win + (size_t)kb * 64 * RIN + nb * 64; j.ldw = RIN; j.dst = WINd + (size_t)nb * 64 * D + kb * 64; j.ldt = D; return j; }
        r -= 32 * 192;
        if (r < 64 * 32) { const int kb = r / 32, nb = r % 32; j.src = wout + (size_t)kb * 64 * D + nb * 64; j.ldw = D; j.dst = WOUTd + (size_t)nb * 64 * VD + kb * 64; j.ldt = VD; return j; }
        r -= 64 * 32;
        { const int g = r >> 6, t = r & 63, kb = t >> 3, nb = t & 7; j.src = wpool + (size_t)g * 512 * 512 + (size_t)kb * 64 * 512 + nb * 64; j.ldw = 512; j.dst = WPOOLd + (size_t)g * 512 * 512 + (size_t)nb * 64 * 512 + kb * 64; j.ldt = 512; return j; }
    }
};
struct JobExp {
    const float *eg, *eu, *ed, *sg, *su, *sd; bf16 *W13, *W2; int layer, mode;
    __device__ __forceinline__ int count() const { return NE1 * (mode == 0 ? 512 : mode == 1 ? 256 : 768); }
    __device__ __forceinline__ ConvJob operator()(int it) const {
        const int per = (mode == 0 ? 512 : mode == 1 ? 256 : 768);
        const int e = it / per; int r = it - e * per; if (mode == 1) r += 512;
        const int mat = r >> 8, t = r & 255;
        ConvJob j; j.scale = (mat < 2) ? 1.0f : 64.0f;
        if (mat < 2) {
            const float* We = mat ? eu : eg; const float* Ws = mat ? su : sg;
            const float* W = (e < NE) ? We + ((size_t)layer * NE + e) * (size_t)(D * ED) : Ws + (size_t)layer * (D * ED);
            const int kb = t >> 3, n0 = (t & 7) * 64;
            j.src = W + (size_t)kb * 64 * ED + n0; j.ldw = ED;
            j.dst = W13 + (size_t)e * W13_E + (size_t)((n0 >> 7) * 256 + (n0 & 127) + mat * 128) * D + kb * 64; j.ldt = D;
        } else {
            const float* W = (e < NE) ? ed + ((size_t)layer * NE + e) * (size_t)(ED * D) : sd + (size_t)layer * (ED * D);
            const int kb = t >> 5, nb = t & 31;
            j.src = W + (size_t)kb * 64 * D + nb * 64; j.ldw = D;
            j.dst = W2 + (size_t)e * W2_E + (size_t)nb * 64 * ED + kb * 64; j.ldt = ED;
        }
        return j;
    }
};
struct JobTail {
    JobExp a, b; int from;
    __device__ __forceinline__ int count() const { return (a.count() - from) + b.count(); }
    __device__ __forceinline__ ConvJob operator()(int it) const { const int na = a.count() - from; return it < na ? a(from + it) : b(it - na); }
};
struct JobFrom {
    JobExp b; int from;
    __device__ __forceinline__ int count() const { return b.count() - from; }
    __device__ __forceinline__ ConvJob operator()(int it) const { return b(from + it); }
};
template <class Dec>
__device__ __forceinline__ void conv_loop(const Dec& dec, int first, int stride, int n, LAS float* scr, int lane) {
    for (int it = first; it < n; it += 3 * stride) {
        const bool h1 = it + stride < n, h2 = it + 2 * stride < n;
        const ConvJob j0 = dec(it); ConvJob j1 = j0, j2 = j0;
        f32x4 v0[16], v1[16], v2[16];
        conv_load(j0, v0, lane);
        if (h1) { j1 = dec(it + stride); conv_load(j1, v1, lane); }
        if (h2) { j2 = dec(it + 2 * stride); conv_load(j2, v2, lane); }
        conv_store(j0, v0, scr, lane);
        if (h1) conv_store(j1, v1, scr, lane);
        if (h2) conv_store(j2, v2, scr, lane);
    }
}
struct Roles { int is_conv, g_rank, g_count, c_rank, c_count; };
__device__ __forceinline__ Roles make_roles(const Frame& F, int nper) {
    Roles r; const int per = F.G / 8, bx = blockIdx.x, x = bx % 8, rix = bx / 8;
    if (F.G % 8 != 0 || nper <= 0 || nper >= per) { r.is_conv = 0; r.g_rank = F.vcu; r.g_count = F.G; r.c_rank = F.vcu; r.c_count = F.G; return r; }
    r.is_conv = rix >= per - nper; r.g_rank = x * (per - nper) + rix; r.g_count = 8 * (per - nper); r.c_rank = x * nper + (rix - (per - nper)); r.c_count = 8 * nper;
    return r;
}
__device__ __forceinline__ void sincos_d(double a, float& s, float& c) {
    const double TWO_PI = 6.283185307179586476925286766559;
    const double k = __builtin_rint(a / TWO_PI);
    const double r = a - k * TWO_PI;
    const double r2 = r * r;
    double ts = r, tc = 1.0, ss = r, cc = 1.0;
#pragma unroll
    for (int i = 1; i <= 14; ++i) { tc = -tc * r2 / (double)((2 * i - 1) * (2 * i)); ts = -ts * r2 / (double)((2 * i) * (2 * i + 1)); cc += tc; ss += ts; }
    s = (float)ss; c = (float)cc;
}

__device__ __forceinline__ void build_moe_tab(Frame& F, int layer, int ntok) {
    int tid_ = (int)threadIdx.x; asm volatile("" : "+v"(tid_));
    if (tid_ < 64) {
        const int cnt = (int)__hip_atomic_load(F.ctl + CW_CNT + (layer * 64 + tid_) * 64, RLX_AGENT);
        F.TAB[66 + tid_] = cnt;
        const int pn = (cnt + 255) >> 8;
        int incl = pn;
#pragma unroll
        for (int o = 1; o < 64; o <<= 1) { const int t = __shfl_up(incl, o); if ((tid_ & 63) >= o) incl += t; }
        F.TAB[tid_ + 1] = incl;
        if (tid_ == 0) F.TAB[0] = 0;
        if (tid_ == 63) F.TAB[65] = incl + ntok / 256;
    }
    LDS_WAIT();
    __syncthreads();
}

struct Args { const float* in[24]; float* out; unsigned char* ws; int ph_lo, ph_hi; };

#ifndef PH_MASK
#define PH_MASK 0x3ffff
#endif
#define IN(k) ((((PH_MASK) >> ((k) >= 14 ? (k) - 6 : (k))) & 1) && lo <= (k) && (k) < hi)
#define SEAM(k) do { if (IN(k) && IN((k) + 1)) xcd_barrier(bar); } while (0)

#define MOD ((float*)(ws + WS_MOD))
#define ROPER ((float*)(ws + WS_ROPE))
#define ROPEC (ROPER + 128 * 64 * 2)
#define L2F ((float*)(ws + WS_L2G))
#define L2B (L2F + 8)
#define RW ((bf16*)(ws + WS_RW))
#define TOKE ((int*)(ws + WS_TOKE))
#define TOKP ((int*)(ws + WS_TOKP))
#define ROWL ((int*)(ws + WS_ROWL))
#define SLOTG ((float*)(ws + WS_SLOTG))
#define WIN ((bf16*)(ws + WS_WIN))
#define WOUT ((bf16*)(ws + WS_WOUT))
#define WPOOL ((bf16*)(ws + WS_WPOOL))
#define HB ((bf16*)(ws + WS_HB))
#define XL ((float*)(ws + WS_XL))
#define R1 ((float*)(ws + WS_R1))
#define KR ((bf16*)(ws + WS_KR))
#define KDTF ((bf16*)(ws + WS_KDTF))
#define KDTB ((bf16*)(ws + WS_KDTB))
#define PQ ((bf16*)(ws + WS_PQ))
#define VS ((bf16*)(ws + WS_VS))
#define UB ((bf16*)(ws + WS_U))
#define GS ((bf16*)(ws + WS_GS))
#define OB ((bf16*)(ws + WS_O))
#define A2 ((bf16*)(ws + WS_A2))
#define ACT ((bf16*)(ws + WS_ACT))
#define YB ((unsigned char*)(ws + WS_Y))
template <int layer>
__device__ __forceinline__ void layer_tail(Frame& F, const Args& args, const int lo, const int hi, const XcdBarrier& bar) {
    unsigned char* const ws = args.ws;
    const int gw = F.vcu * NWAVES + F.wave, NGW = F.G * NWAVES;
    LAS float* scr = (LAS float*)(F.lds + F.wave * 16640);
        const int ntok = NLAT;
        const int pb = layer ? 14 : 8;
        const float* modL = MOD + (size_t)layer * 3 * MODW;
        bf16* W13 = (bf16*)(ws + (layer ? WS_W13_1 : WS_W13_0)); bf16* W2 = (bf16*)(ws + (layer ? WS_W2_1 : WS_W2_0));
        unsigned* cntw = F.ctl + CW_CNT + layer * 64 * 64;

        if (layer == 1) {
            if (IN(12)) {
                for (int it = gw; it < 256 * 8; it += NGW) {
                    const int grow = it >> 3, ch = it & 7, c = ch * 256 + F.lane * 4;
                    const int wdw = 2 << (c >> 9), hw = wdw >> 1;
                    const float* md = MOD + (size_t)(3 + (grow >> 7)) * MODW;
                    const f32x4 sh = *(const f32x4*)(md + c), sc = *(const f32x4*)(md + D + c) + 1.0f;
                    const float* xb = XL + (size_t)grow * 64 * D + c;
                    f32x4 sum = {0.f, 0.f, 0.f, 0.f};
                    for (int j = 0; j < hw; ++j) sum += *(const f32x4*)(xb + (size_t)j * D) * sc + sh;
#pragma unroll 4
                    for (int t = 0; t < 64; ++t) {
                        const int lo2 = (t - hw) < 0 ? 0 : (t - hw), hi2 = (t + hw) > 64 ? 64 : (t + hw);
                        const f32x4 self = *(const f32x4*)(xb + (size_t)t * D) * sc + sh;
                        const f32x4 p = sum * (1.0f / (float)(hi2 - lo2)) - self;
                        u32x2 w; w.x = cvt_pk_bf16(p[0], p[1]); w.y = cvt_pk_bf16(p[2], p[3]);
                        *(u32x2*)(HB + ((size_t)grow * 64 + t) * D + c) = w;
                        if (t + hw < 64) sum += *(const f32x4*)(xb + (size_t)(t + hw) * D) * sc + sh;
                        if (t - hw >= 0) sum -= *(const f32x4*)(xb + (size_t)(t - hw) * D) * sc + sh;
                    }
                }
            }
            SEAM(12);
            if (IN(13)) {
                SchedPool S{(const char*)HB, (const char*)WPOOL, F.G, F.vcu};
                EpiResid E{R1, XL, XL, NLAT, MOD + (size_t)3 * MODW + 2 * D, args.in[15], 1};
                gemm_run<4>(F.lds, Dims{D, 512, 512}, S, E);
            }
            SEAM(13);
        }

        if (IN(pb)) {
            const float* lng = args.in[6] + (size_t)layer * D; const float* lnb = args.in[7] + (size_t)layer * D;
            const bf16* rwh = RW + (size_t)(layer * 2) * NE * D; const bf16* rwl = rwh + (size_t)NE * D;
            const float* rbias = args.in[17] + layer * NE;
            LAS float* PART = (LAS float*)F.lds;
            bf16* HL = (bf16*)(ws + WS_Y);
            const int fr = F.lane & 15, fq = F.lane >> 4;
            const float rb = rbias[F.lane];
            LAS int* LCNT = F.TAB + 512; LAS int* LBASE = F.TAB + 576; LAS int* ASG = F.TAB + 640; LAS float* ASGG = (LAS float*)(F.TAB + 1152);
            const int nblocks = ntok / 16;
            for (int blk0 = F.vcu; blk0 < nblocks; blk0 += 4 * F.G) {
                int nst = 0;
#pragma unroll
                for (int q = 0; q < 4; ++q) nst += (blk0 + q * F.G < nblocks) ? 1 : 0;
                if (F.tid < 64) LCNT[F.tid] = 0;
                f32x4 xa[2][8];
#pragma unroll
                for (int rr = 0; rr < 2; ++rr)
#pragma unroll
                    for (int j = 0; j < 8; ++j) xa[rr][j] = *(const f32x4*)(R1 + (size_t)(blk0 * 16 + 2 * F.wave + rr) * D + j * 256 + F.lane * 4);
                for (int st = 0; st < nst; ++st) {
                    const int r0 = (blk0 + st * F.G) * 16;
                    const float* md = modL + (size_t)(r0 >> 13) * MODW;
                    float rs2[2];
#pragma unroll
                    for (int rr = 0; rr < 2; ++rr) {
                        float sm = 0.f;
#pragma unroll
                        for (int j = 0; j < 8; ++j) sm += (xa[rr][j][0] + xa[rr][j][1]) + (xa[rr][j][2] + xa[rr][j][3]);
                        const float mu = wave_sum(sm) * (1.0f / D); float sq = 0.f;
#pragma unroll
                        for (int j = 0; j < 8; ++j) { xa[rr][j] = xa[rr][j] - mu; sq += (xa[rr][j][0] * xa[rr][j][0] + xa[rr][j][1] * xa[rr][j][1]) + (xa[rr][j][2] * xa[rr][j][2] + xa[rr][j][3] * xa[rr][j][3]); }
                        rs2[rr] = 1.0f / sqrtf(wave_sum(sq) * (1.0f / D) + LN_EPS);
                    }
#pragma unroll
                    for (int rr = 0; rr < 2; ++rr) {
                        const size_t ro = (size_t)(r0 + 2 * F.wave + rr) * D;
#pragma unroll
                        for (int jh = 0; jh < 8; jh += 4) {
                            f32x4 vg[4], vb[4], vsc[4], vsh[4];
#pragma unroll
                            for (int j2 = 0; j2 < 4; ++j2) { const int c = (jh + j2) * 256 + F.lane * 4; vg[j2] = *(const f32x4*)(lng + c); vb[j2] = *(const f32x4*)(lnb + c); vsc[j2] = *(const f32x4*)(md + 4 * D + c); vsh[j2] = *(const f32x4*)(md + 3 * D + c); }
#pragma unroll
                            for (int j2 = 0; j2 < 4; ++j2) {
                                const int j = jh + j2, c = j * 256 + F.lane * 4;
                                const f32x4 y = xa[rr][j] * rs2[rr] * vg[j2] + vb[j2];
                                *(f32x4*)(XL + ro + c) = y;
                                const f32x4 hh = y * (vsc[j2] + 1.0f) + vsh[j2];
                                u32x2 wh, wl;
                                const unsigned b0 = f2bf(hh[0]), b1 = f2bf(hh[1]), b2 = f2bf(hh[2]), b3 = f2bf(hh[3]);
                                wh.x = b0 | (b1 << 16); wh.y = b2 | (b3 << 16);
                                wl.x = cvt_pk_bf16(hh[0] - bf2f(b0), hh[1] - bf2f(b1)); wl.y = cvt_pk_bf16(hh[2] - bf2f(b2), hh[3] - bf2f(b3));
                                *(u32x2*)(HB + ro + c) = wh;
                                *(u32x2*)(HL + ro + c) = wl;
                            }
                        }
                    }
                    {
                        const int nb = (st + 1 < nst) ? blk0 + (st + 1) * F.G : blk0 + st * F.G;
#pragma unroll
                        for (int rr = 0; rr < 2; ++rr)
#pragma unroll
                            for (int j = 0; j < 8; ++j) xa[rr][j] = *(const f32x4*)(R1 + (size_t)(nb * 16 + 2 * F.wave + rr) * D + j * 256 + F.lane * 4);
                    }
                }
                VM_WAIT(); LDS_WAIT(); __syncthreads();
                f32x4 lg[4][4];
#pragma unroll
                for (int st = 0; st < 4; ++st)
#pragma unroll
                    for (int j = 0; j < 4; ++j) lg[st][j] = (f32x4){0.f, 0.f, 0.f, 0.f};
#pragma unroll 2
                for (int ks = 0; ks < 8; ++ks) {
                    const int c = 256 * F.wave + ks * 32 + fq * 8;
                    bf16x8 bh[4], bl[4];
#pragma unroll
                    for (int j = 0; j < 4; ++j) { bh[j] = *(const bf16x8*)(rwh + (size_t)(16 * j + fr) * D + c); bl[j] = *(const bf16x8*)(rwl + (size_t)(16 * j + fr) * D + c); }
#pragma unroll
                    for (int st = 0; st < 4; ++st) {
                        const int bb = (st < nst) ? blk0 + st * F.G : blk0;
                        const size_t ao = (size_t)(bb * 16 + fr) * D + c;
                        const bf16x8 ah = *(const bf16x8*)(HB + ao), al = *(const bf16x8*)(HL + ao);
#pragma unroll
                        for (int j = 0; j < 4; ++j) {
                            lg[st][j] = __builtin_amdgcn_mfma_f32_16x16x32_bf16(ah, bh[j], lg[st][j], 0, 0, 0);
                            lg[st][j] = __builtin_amdgcn_mfma_f32_16x16x32_bf16(al, bh[j], lg[st][j], 0, 0, 0);
                            lg[st][j] = __builtin_amdgcn_mfma_f32_16x16x32_bf16(ah, bl[j], lg[st][j], 0, 0, 0);
                        }
                    }
                }
#pragma unroll
                for (int st = 0; st < 4; ++st)
#pragma unroll
                    for (int j = 0; j < 4; ++j)
#pragma unroll
                        for (int q = 0; q < 4; ++q) PART[F.wave * 4096 + (st * 16 + 4 * fq + q) * 64 + 16 * j + fr] = lg[st][j][q];
                LDS_WAIT(); __syncthreads();
                for (int tt = 0; tt < 8; ++tt) {
                    const int q = 8 * F.wave + tt;
                    if ((q >> 4) >= nst) break;
                    float logit = 0.f;
#pragma unroll
                    for (int w2 = 0; w2 < 8; ++w2) logit += PART[w2 * 4096 + q * 64 + F.lane];
                    const float score = 1.0f / (1.0f + __expf(-logit));
                    const float bsd = score + rb;
                    float m1 = bsd;
                    m1 = fmaxf(m1, __shfl_xor(m1, 1)); m1 = fmaxf(m1, __shfl_xor(m1, 2)); m1 = fmaxf(m1, __shfl_xor(m1, 4));
                    const unsigned long long eqm = __ballot(bsd == m1);
                    const unsigned seg = (unsigned)(eqm >> (F.lane & ~7)) & 0xffu;
                    const int first = __builtin_ctz(seg);
                    float m2 = ((F.lane & 7) == first) ? -__builtin_inff() : bsd;
                    m2 = fmaxf(m2, __shfl_xor(m2, 1)); m2 = fmaxf(m2, __shfl_xor(m2, 2)); m2 = fmaxf(m2, __shfl_xor(m2, 4));
                    const float gs = m1 + m2;
                    int grank = 0; const int myg = F.lane >> 3;
#pragma unroll
                    for (int g2 = 0; g2 < 8; ++g2) { const float o = __shfl(gs, g2 * 8); grank += (o > gs || (o == gs && g2 < myg)) ? 1 : 0; }
                    const float mv = (grank < 4) ? bsd : -__builtin_inff();
                    int rank = 0;
                    unsigned long long gbits = __ballot(grank < 4) & 0x0101010101010101ull;
#pragma unroll 1
                    for (int it = 0; it < 4; ++it) {
                        const int b0 = __builtin_amdgcn_readfirstlane((int)__builtin_ctzll(gbits)); gbits &= gbits - 1;
#pragma unroll
                        for (int j2 = 0; j2 < 8; ++j2) { const int e2 = b0 + j2; const float o = __builtin_bit_cast(float, __builtin_amdgcn_readlane(__builtin_bit_cast(int, mv), e2)); rank += (o > mv || (o == mv && e2 < F.lane)) ? 1 : 0; }
                    }
                    const bool sel = rank < 8;
                    const float ssum = wave_sum(sel ? score : 0.f);
                    if (sel) {
                        const float gate = score / ssum * ROUTED_SCALE;
                        const int local = __hip_atomic_fetch_add(LCNT + F.lane, 1, __ATOMIC_RELAXED, __HIP_MEMORY_SCOPE_WORKGROUP);
                        ASG[q * 8 + rank] = F.lane | (local << 8); ASGG[q * 8 + rank] = gate;
                    }
                }
                LDS_WAIT(); __syncthreads();
                if (F.tid < 64) { const int c = LCNT[F.tid]; LBASE[F.tid] = c ? (int)__hip_atomic_fetch_add(cntw + F.tid * 64, (unsigned)c, RLX_AGENT) : 0; }
                LDS_WAIT(); __syncthreads();
                if (F.tid < nst * 128) {
                    const int q = F.tid >> 3, rank = F.tid & 7, a = ASG[F.tid], e = a & 0xff, pos = LBASE[e] + (a >> 8);
                    const int t = (blk0 + (q >> 4) * F.G) * 16 + (q & 15);
                    ROWL[(size_t)e * CAP + pos] = t; SLOTG[(size_t)t * 8 + rank] = ASGG[F.tid];
                    TOKE[(size_t)t * 8 + rank] = e; TOKP[(size_t)t * 8 + rank] = pos;
                }
                LDS_WAIT(); __syncthreads();
            }
            if (layer == 0 && (CONV_P9 == 0 || CONV_P10 == 0 || F.G % 8 != 0 || CONV_P9 >= F.G / 8)) {
                __syncthreads();
                JobExp dec{args.in[18], args.in[19], args.in[20], args.in[21], args.in[22], args.in[23], (bf16*)(ws + WS_W13_1), (bf16*)(ws + WS_W2_1), 1, 2};
                conv_loop(dec, gw, NGW, dec.count(), scr, F.lane);
            }
        }
        SEAM(pb);

        if (IN(pb + 1)) {
            build_moe_tab(F, layer, ntok);
            const int late = (F.G % 8 == 0 && CONV_P15 > 0 && CONV_P15 < F.G / 8) ? W2_LATE : 0;
            const Roles R = make_roles(F, layer == 0 ? (CONV_P10 > 0 ? CONV_P9 : 0) : (late > 0 ? CONV_P15 : 0));
            if (!R.is_conv) {
                SchedMoE S{F.TAB, (const char*)HB, (const char*)W13, ROWL, 4, D * 2, R.g_count, R.g_rank, 1, W13_E * 2, (size_t)256 * D * 2};
                EpiMoe1 E{ACT};
                gemm_run<5, EpiMoe1, SchedMoE, true>(F.lds, Dims{D, D, D}, S, E);
            } else if (layer == 1) {
                JobExp d1{args.in[18], args.in[19], args.in[20], args.in[21], args.in[22], args.in[23], (bf16*)(ws + WS_W13_1), (bf16*)(ws + WS_W2_1), 1, 1};
                JobFrom dec{d1, d1.count() - late};
                conv_loop(dec, R.c_rank * NWAVES + F.wave, R.c_count * NWAVES, dec.count(), scr, F.lane);
            } else {
                JobExp dec{args.in[18], args.in[19], args.in[20], args.in[21], args.in[22], args.in[23], (bf16*)(ws + WS_W13_1), (bf16*)(ws + WS_W2_1), 1, 0};
                conv_loop(dec, R.c_rank * NWAVES + F.wave, R.c_count * NWAVES, W13_SPLIT < dec.count() ? W13_SPLIT : dec.count(), scr, F.lane);
            }
            __syncthreads();
        }
        SEAM(pb + 1);

        if (IN(pb + 2)) {
            build_moe_tab(F, layer, ntok);
            const Roles R = make_roles(F, (layer == 0 && CONV_P9 > 0) ? CONV_P10 : 0);
            if (!R.is_conv) {
                SchedMoE S{F.TAB, (const char*)ACT, (const char*)W2, ROWL, 8, ED * 2, R.g_count, R.g_rank, 0, W2_E * 2, (size_t)256 * ED * 2};
                EpiMoe2 E{YB};
                gemm_run<6>(F.lds, Dims{ED, ED, ED}, S, E);
            } else {
                JobExp d0{args.in[18], args.in[19], args.in[20], args.in[21], args.in[22], args.in[23], (bf16*)(ws + WS_W13_1), (bf16*)(ws + WS_W2_1), 1, 0};
                JobExp d1{args.in[18], args.in[19], args.in[20], args.in[21], args.in[22], args.in[23], (bf16*)(ws + WS_W13_1), (bf16*)(ws + WS_W2_1), 1, 1};
                JobTail dec{d0, d1, W13_SPLIT < d0.count() ? W13_SPLIT : d0.count()};
                const int late = (F.G % 8 == 0 && CONV_P15 > 0 && CONV_P15 < F.G / 8) ? W2_LATE : 0;
                conv_loop(dec, R.c_rank * NWAVES + F.wave, R.c_count * NWAVES, dec.count() - late, scr, F.lane);
            }
            __syncthreads();
        }
        SEAM(pb + 2);

        if (IN(pb + 3)) {
            build_moe_tab(F, layer, ntok);
            const float* lng = args.in[8] + (size_t)layer * D; const float* lnb = args.in[9] + (size_t)layer * D;
            float* dst = layer ? F.out : XL;
            int eN[8], pN[8]; float gN[8], gC[8];
            u32x2 yv[4][9]; f32x4 xr_[8];
            {
                const int t = (gw < ntok) ? gw : 0, t1 = (t + NGW < ntok) ? t + NGW : t;
                int slot[9];
#pragma unroll
                for (int k = 0; k < 8; ++k) slot[k] = F.TAB[TOKE[(size_t)t * 8 + k]] * 256 + TOKP[(size_t)t * 8 + k];
                slot[8] = F.TAB[64] * 256 + t;
#pragma unroll
                for (int j = 0; j < 4; ++j) {
                    const int c = j * 512 + F.lane * 8;
#pragma unroll
                    for (int k = 0; k < 9; ++k) yv[j][k] = *(const u32x2*)(YB + (size_t)slot[k] * D + c);
                    xr_[2 * j] = *(const f32x4*)(XL + (size_t)t * D + c); xr_[2 * j + 1] = *(const f32x4*)(XL + (size_t)t * D + c + 4);
                }
#pragma unroll
                for (int k = 0; k < 8; ++k) { eN[k] = TOKE[(size_t)t1 * 8 + k]; pN[k] = TOKP[(size_t)t1 * 8 + k]; gN[k] = SLOTG[(size_t)t1 * 8 + k]; gC[k] = SLOTG[(size_t)t * 8 + k]; }
            }
            for (int t = gw; t < ntok; t += NGW) {
                const int v = (t < NLAT) ? (t >> 13) : 2;
                const float* g2 = modL + (size_t)v * MODW + 5 * D;
                f32x4 x[8]; float sm = 0.f;
#pragma unroll
                for (int j = 0; j < 4; ++j) {
                    const int c = j * 512 + F.lane * 8;
                    f32x4 f0 = {0.f, 0.f, 0.f, 0.f}, f1 = {0.f, 0.f, 0.f, 0.f};
#pragma unroll
                    for (int k = 0; k < 9; ++k) {
                        const u32x2 y2 = yv[j][k];
                        const float g = (k < 8) ? gC[k < 8 ? k : 0] : 1.0f;
                        f0[0] += g * __builtin_amdgcn_cvt_f32_fp8((int)y2.x, 0); f0[1] += g * __builtin_amdgcn_cvt_f32_fp8((int)y2.x, 1); f0[2] += g * __builtin_amdgcn_cvt_f32_fp8((int)y2.x, 2); f0[3] += g * __builtin_amdgcn_cvt_f32_fp8((int)y2.x, 3);
                        f1[0] += g * __builtin_amdgcn_cvt_f32_fp8((int)y2.y, 0); f1[1] += g * __builtin_amdgcn_cvt_f32_fp8((int)y2.y, 1); f1[2] += g * __builtin_amdgcn_cvt_f32_fp8((int)y2.y, 2); f1[3] += g * __builtin_amdgcn_cvt_f32_fp8((int)y2.y, 3);
                    }
                    x[2 * j] = xr_[2 * j] * ALPHA + *(const f32x4*)(g2 + c) * (f0 * (1.0f / Y_SCALE));
                    x[2 * j + 1] = xr_[2 * j + 1] * ALPHA + *(const f32x4*)(g2 + c + 4) * (f1 * (1.0f / Y_SCALE));
                    sm += (x[2 * j][0] + x[2 * j][1]) + (x[2 * j][2] + x[2 * j][3]) + (x[2 * j + 1][0] + x[2 * j + 1][1]) + (x[2 * j + 1][2] + x[2 * j + 1][3]);
                }
                const int tn = (t + NGW < ntok) ? t + NGW : t, tnn = (tn + NGW < ntok) ? tn + NGW : tn;
                {
                    int slot[9];
#pragma unroll
                    for (int k = 0; k < 8; ++k) slot[k] = F.TAB[eN[k]] * 256 + pN[k];
                    slot[8] = F.TAB[64] * 256 + tn;
#pragma unroll
                    for (int j = 0; j < 4; ++j) {
                        const int c = j * 512 + F.lane * 8;
#pragma unroll
                        for (int k = 0; k < 9; ++k) yv[j][k] = *(const u32x2*)(YB + (size_t)slot[k] * D + c);
                        xr_[2 * j] = *(const f32x4*)(XL + (size_t)tn * D + c); xr_[2 * j + 1] = *(const f32x4*)(XL + (size_t)tn * D + c + 4);
                    }
#pragma unroll
                    for (int k = 0; k < 8; ++k) { gC[k] = gN[k]; eN[k] = TOKE[(size_t)tnn * 8 + k]; pN[k] = TOKP[(size_t)tnn * 8 + k]; gN[k] = SLOTG[(size_t)tnn * 8 + k]; }
                }
                const float mu = wave_sum(sm) * (1.0f / D); float sq = 0.f;
#pragma unroll
                for (int j = 0; j < 8; ++j) { x[j] = x[j] - mu; sq += (x[j][0] * x[j][0] + x[j][1] * x[j][1]) + (x[j][2] * x[j][2] + x[j][3] * x[j][3]); }
                const float rstd = 1.0f / sqrtf(wave_sum(sq) * (1.0f / D) + LN_EPS);
#pragma unroll
                for (int j = 0; j < 4; ++j) {
                    const int c = j * 512 + F.lane * 8;
                    *(f32x4*)(dst + (size_t)t * D + c) = x[2 * j] * rstd * *(const f32x4*)(lng + c) + *(const f32x4*)(lnb + c);
                    *(f32x4*)(dst + (size_t)t * D + c + 4) = x[2 * j + 1] * rstd * *(const f32x4*)(lng + c + 4) + *(const f32x4*)(lnb + c + 4);
                }
            }
            __syncthreads();
        }
        SEAM(pb + 3);
    }

__global__ void __launch_bounds__(NWAVES * 64, 2) mk_fwd(Args args) {
    extern __shared__ __attribute__((aligned(16))) unsigned char lds_raw[];
    Frame F;
    F.lds = (LAS unsigned char*)lds_raw;
    F.TAB = (LAS int*)(F.lds + LDSCTL_OFF);
    F.MISC = (volatile LAS unsigned*)(F.lds + LDSCTL_OFF + 1024);
    F.tid = threadIdx.x; F.lane = F.tid & 63; F.wave = __builtin_amdgcn_readfirstlane(F.tid >> 6);
    F.G = gridDim.x; { const int bx = blockIdx.x; F.vcu = (F.G % 8 == 0) ? (bx % 8) * (F.G / 8) + bx / 8 : bx; }
    F.ws = args.ws; F.ctl = (unsigned*)(args.ws + WS_CTL); F.out = args.out;
    for (int u = F.tid; u < (LDS_BYTES - LDSCTL_OFF) / 4; u += NWAVES * 64) ((LAS unsigned*)(F.lds + LDSCTL_OFF))[u] = 0u;
    __syncthreads();
    const int lo = args.ph_lo, hi = args.ph_hi;
    XcdBarrier bar; bar.bar = (unsigned*)(F.ctl + CW_BAR); bar.x = 0; bar.st = nullptr;
    if (hi - lo > 1) bar = xcd_barrier_post((unsigned*)(F.ctl + CW_BAR) + (size_t)lo * XCD_BAR_WORDS, F.MISC + 8);
    unsigned char* const ws = args.ws;
    const int gw = F.vcu * NWAVES + F.wave, NGW = F.G * NWAVES;
    LAS float* scr = (LAS float*)(F.lds + F.wave * 16640);

    if (IN(0)) {
        for (int it = F.vcu; it < 2 * 96; it += F.G) {
            const int l = it / 96, c0 = (it % 96) * 128 + 2 * F.lane;
            const float* W = args.in[4] + (size_t)l * D * MODW + c0;
            f32x2 a0 = {0.f, 0.f}, a1 = {0.f, 0.f}, a2 = {0.f, 0.f};
            for (int kc = 256 * F.wave; kc < 256 * F.wave + 256; kc += 64) {
                const float s0 = silu_f(args.in[1][kc + F.lane]), s1 = silu_f(args.in[1][D + kc + F.lane]), s2 = silu_f(args.in[3][kc + F.lane]);
#pragma unroll 16
                for (int kk = 0; kk < 64; ++kk) {
                    const f32x2 w = *(const f32x2*)(W + (size_t)(kc + kk) * MODW);
                    const float b0 = __builtin_bit_cast(float, __builtin_amdgcn_readlane(__builtin_bit_cast(int, s0), kk)), b1 = __builtin_bit_cast(float, __builtin_amdgcn_readlane(__builtin_bit_cast(int, s1), kk)), b2 = __builtin_bit_cast(float, __builtin_amdgcn_readlane(__builtin_bit_cast(int, s2), kk));
                    a0 += w * b0; a1 += w * b1; a2 += w * b2;
                }
            }
            LAS f32x2* red = (LAS f32x2*)F.lds;
            red[(F.wave * 3 + 0) * 64 + F.lane] = a0; red[(F.wave * 3 + 1) * 64 + F.lane] = a1; red[(F.wave * 3 + 2) * 64 + F.lane] = a2;
            LDS_WAIT(); __syncthreads();
            if (F.wave < 3) {
                f32x2 t = {0.f, 0.f};
#pragma unroll
                for (int w2 = 0; w2 < 8; ++w2) t += red[(w2 * 3 + F.wave) * 64 + F.lane];
                const f32x2 bb = *(const f32x2*)(args.in[5] + (size_t)l * MODW + c0);
                *(f32x2*)(MOD + ((size_t)l * 3 + F.wave) * MODW + c0) = t + bb;
            }
            LDS_WAIT(); __syncthreads();
        }
        const int gt = F.vcu * 512 + F.tid, NGT = F.G * 512;
        for (int i = gt; i < 192 * 64; i += NGT) {
            const int j = i & 63, rc = i >> 6;
            double fr = 1.0; for (int q = 0; q < j; ++q) fr *= 0.8659643233600653;
            const double ang = (double)(rc < 128 ? rc : rc - 128) * fr;
            float s, c; sincos_d(ang, s, c);
            float* dst = (rc < 128) ? ROPER + ((size_t)rc * 64 + j) * 2 : ROPEC + ((size_t)(rc - 128) * 64 + j) * 2;
            dst[0] = c; dst[1] = s;
        }
        if (gt < 16) { const float raw = (gt < 8) ? args.in[12][gt] : args.in[13][gt - 8];
            const float v = -log1pf(expf(-raw)) * 1.44269504088896341f; if (gt < 8) L2F[gt] = v; else L2B[gt - 8] = v; }
        for (int i = gt; i < 2 * D * NE; i += NGT) {
            const int l = i / (D * NE), r = i % (D * NE), k = r / NE, e = r % NE;
            const float w = args.in[16][i]; const unsigned whi = f2bf(w); const float wlo = w - bf2f(whi);
            RW[((size_t)(l * 2 + 0) * NE + e) * D + k] = (bf16)whi; RW[((size_t)(l * 2 + 1) * NE + e) * D + k] = (bf16)f2bf(wlo);
        }
        { JobP0 dec{args.in[10], args.in[11], args.in[14], WIN, WOUT, WPOOL}; conv_loop(dec, gw, NGW, JobP0::N, scr, F.lane); }
        if (CONV_P2 == 0 || F.G % 8 != 0 || CONV_P2 >= F.G / 8) { JobExp dec{args.in[18], args.in[19], args.in[20], args.in[21], args.in[22], args.in[23], (bf16*)(ws + WS_W13_0), (bf16*)(ws + WS_W2_0), 0, 2}; conv_loop(dec, gw, NGW, dec.count(), scr, F.lane); }
    }
    SEAM(0);

    if (IN(1)) {
        for (int r = gw; r < NTOK0; r += NGW) {
            const float* xr = (r < NLAT) ? args.in[0] + (size_t)r * D : args.in[2] + (size_t)(r - NLAT) * D;
            const int v = (r < NLAT) ? (r >> 13) : 2;
            const float* md = MOD + (size_t)v * MODW;
#pragma unroll
            for (int j = 0; j < 4; ++j) {
                const int c = j * 512 + F.lane * 8;
                const f32x4 x0 = *(const f32x4*)(xr + c), x1 = *(const f32x4*)(xr + c + 4);
                const f32x4 h0 = *(const f32x4*)(md + c), h1 = *(const f32x4*)(md + c + 4), s0 = *(const f32x4*)(md + D + c), s1 = *(const f32x4*)(md + D + c + 4);
                *(u32x4*)(HB + (size_t)r * D + c) = pack8(x0 * (s0 + 1.0f) + h0, x1 * (s1 + 1.0f) + h1);
            }
        }
    }
    SEAM(1);

    if (IN(2)) {
        const Roles R = make_roles(F, CONV_P2);
        if (!R.is_conv) {
            SchedWin S{(const char*)HB, (const char*)WIN, R.g_count, R.g_rank};
            EpiWin E{KR, KDTF, KDTB, PQ, VS, GS, ROPER, ROPEC, L2F, L2B};
            gemm_run<0>(F.lds, Dims{D, D, D}, S, E);
        } else {
            JobExp dec{args.in[18], args.in[19], args.in[20], args.in[21], args.in[22], args.in[23], (bf16*)(ws + WS_W13_0), (bf16*)(ws + WS_W2_0), 0, 2};
            conv_loop(dec, R.c_rank * NWAVES + F.wave, R.c_count * NWAVES, dec.count(), scr, F.lane);
        }
    }
    SEAM(2);

    if (IN(3)) {
        SchedRet3 S{(const char*)PQ, (const char*)KR, (const char*)VS, (const char*)KDTF, (size_t)(WS_KDTB - WS_KDTF), F.G, F.vcu};
        EpiRet3 E{PQ, UB, L2F, L2B};
        gemm_run<1>(F.lds, Dims{768, 256, 256}, S, E);
    }
    SEAM(3);

    if (IN(4)) {
        const int gt = F.vcu * 512 + F.tid, NGT = F.G * 512;
        for (int it = gt; it < 16 * 2 * 512 * 32; it += NGT) {
            const int dkc = it & 31, dv = (it >> 5) & 511, dir = (it >> 14) & 1, bh = it >> 15, b = bh >> 3, h = bh & 7;
            const float dec = exp2f((dir ? L2B[h] : L2F[h]) * 256.0f);
            float s[8];
#pragma unroll
            for (int j = 0; j < 8; ++j) s[j] = 0.f;
            for (int st = 0; st < 33; ++st) {
                const int pm = (st == 0) ? 64 + b : b * 32 + (dir ? 32 - st : st - 1);
                const size_t idx = (size_t)pm * 8 + h;
                u32x4 w; w.x = cvt_pk_bf16(s[0], s[1]); w.y = cvt_pk_bf16(s[2], s[3]); w.z = cvt_pk_bf16(s[4], s[5]); w.w = cvt_pk_bf16(s[6], s[7]);
                *(u32x4*)(VS + idx * VS_E + (size_t)dv * 768 + 256 + dir * 256 + dkc * 8) = w;
                if (st == 32) break;
                const u32x4 uv = *(const u32x4*)(UB + (idx * 2 + dir) * U_E + (size_t)dv * 256 + dkc * 8);
                s[0] = s[0] * dec + bf2f(uv.x & 0xffffu); s[1] = s[1] * dec + bf2f(uv.x >> 16);
                s[2] = s[2] * dec + bf2f(uv.y & 0xffffu); s[3] = s[3] * dec + bf2f(uv.y >> 16);
                s[4] = s[4] * dec + bf2f(uv.z & 0xffffu); s[5] = s[5] * dec + bf2f(uv.z >> 16);
                s[6] = s[6] * dec + bf2f(uv.w & 0xffffu); s[7] = s[7] * dec + bf2f(uv.w >> 16);
            }
        }
    }
    SEAM(4);

    if (IN(5)) {
        SchedO S{(const char*)PQ, (const char*)VS, F.G, F.vcu};
        EpiO E{OB};
        gemm_run<2>(F.lds, Dims{768, 768, 768}, S, E);
    }
    SEAM(5);

    if (IN(6)) {
        for (int it0 = gw; it0 < NLAT * NH; it0 += 4 * NGW) {
            u32x4 ov[4], gv[4]; size_t off[4];
#pragma unroll
            for (int q = 0; q < 4; ++q) { const int it = it0 + q * NGW;
                const int itc = it < NLAT * NH ? it : it0;
                off[q] = (size_t)(itc >> 3) * VD + (size_t)(itc & 7) * 512 + F.lane * 8;
                ov[q] = *(const u32x4*)(OB + off[q]); gv[q] = *(const u32x4*)(GS + off[q]); }
            u32x4 wq[4];
#pragma unroll
            for (int q = 0; q < 4; ++q) {
                float o[8], g[8];
                o[0] = bf2f(ov[q].x & 0xffffu); o[1] = bf2f(ov[q].x >> 16); o[2] = bf2f(ov[q].y & 0xffffu); o[3] = bf2f(ov[q].y >> 16);
                o[4] = bf2f(ov[q].z & 0xffffu); o[5] = bf2f(ov[q].z >> 16); o[6] = bf2f(ov[q].w & 0xffffu); o[7] = bf2f(ov[q].w >> 16);
                g[0] = bf2f(gv[q].x & 0xffffu); g[1] = bf2f(gv[q].x >> 16); g[2] = bf2f(gv[q].y & 0xffffu); g[3] = bf2f(gv[q].y >> 16);
                g[4] = bf2f(gv[q].z & 0xffffu); g[5] = bf2f(gv[q].z >> 16); g[6] = bf2f(gv[q].w & 0xffffu); g[7] = bf2f(gv[q].w >> 16);
#pragma unroll
                for (int j = 0; j < 8; ++j) g[j] = silu_f(g[j]);
                float sm = 0.f;
#pragma unroll
                for (int j = 0; j < 8; ++j) sm += o[j];
                const float mu = wave_sum(sm) * (1.0f / 512.0f);
                float sq = 0.f;
#pragma unroll
                for (int j = 0; j < 8; ++j) { o[j] -= mu; sq += o[j] * o[j]; }
                const float rstd = 1.0f / sqrtf(wave_sum(sq) * (1.0f / 512.0f) + LN_EPS);
                wq[q].x = cvt_pk_bf16(o[0] * rstd * g[0], o[1] * rstd * g[1]); wq[q].y = cvt_pk_bf16(o[2] * rstd * g[2], o[3] * rstd * g[3]);
                wq[q].z = cvt_pk_bf16(o[4] * rstd * g[4], o[5] * rstd * g[5]); wq[q].w = cvt_pk_bf16(o[6] * rstd * g[6], o[7] * rstd * g[7]);
            }
#pragma unroll
            for (int q = 0; q < 4; ++q) if (it0 + q * NGW < NLAT * NH) *(u32x4*)(A2 + off[q]) = wq[q];
        }
    }
    SEAM(6);

    if (IN(7)) {
        SchedDense S{(const char*)A2, (const char*)WOUT, VD, VD, 64, D / 256, 64 * (D / 256), F.G, (int)blockIdx.x};
        EpiResid E{R1, args.in[0], args.in[2], NLAT, MOD + 2 * D, nullptr, 0};
        gemm_run<3>(F.lds, Dims{VD, VD, VD}, S, E);
    }
    SEAM(7);

    layer_tail<0>(F, args, lo, hi, bar);
    layer_tail<1>(F, args, lo, hi, bar);
}

extern "C" void kernel_launch(void* const* d_in, const int* in_sizes, int n_in, void* d_out, int out_size, void* d_ws, size_t ws_size, hipStream_t stream) {
    static int grid = 0;
    if (grid == 0) {
        if (n_in != 24 || in_sizes[0] != NLAT * D || out_size != NLAT * D || ws_size < WS_END) {
            fprintf(stderr, "kernel_launch: unexpected problem (n_in %d, in0 %d, out %d, ws %zu; need ws >= %zu); nothing launched\n", n_in, n_in > 0 ? in_sizes[0] : -1, out_size, ws_size, (size_t)WS_END);
            grid = -1; return; }
        int dev = 0, cus = 0, per_cu = 0;
        if (hipGetDevice(&dev) != hipSuccess || hipDeviceGetAttribute(&cus, hipDeviceAttributeMultiprocessorCount, dev) != hipSuccess) { grid = -1; return; }
        if (hipFuncSetAttribute((const void*)mk_fwd, hipFuncAttributeMaxDynamicSharedMemorySize, LDS_BYTES) != hipSuccess) { fprintf(stderr, "kernel_launch: hipFuncSetAttribute failed\n"); grid = -1; return; }
        if (hipOccupancyMaxActiveBlocksPerMultiprocessor(&per_cu, (const void*)mk_fwd, NWAVES * 64, LDS_BYTES) != hipSuccess || per_cu < 1) {
            fprintf(stderr, "kernel_launch: occupancy query reports %d workgroups per CU\n", per_cu); }
        (void)hipGetLastError();
        grid = cus;
    }
    if (grid < 0) return;
    if (hipMemsetAsync((char*)d_ws + WS_CTL, 0, CTL_ZERO_BYTES, stream) != hipSuccess) { fprintf(stderr, "kernel_launch: memset failed\n"); return; }
    Args a{};
    for (int i = 0; i < 24; ++i) a.in[i] = (const float*)d_in[i];
    a.out = (float*)d_out; a.ws = (unsigned char*)d_ws;
#if MK_PER_PHASE
    for (int p = 0; p < PH_LIMIT; ++p) { a.ph_lo = p; a.ph_hi = p + 1; hipLaunchKernelGGL(mk_fwd, dim3(grid), dim3(NWAVES * 64), LDS_BYTES, stream, a); }
#else
    a.ph_lo = 0; a.ph_hi = NPH; hipLaunchKernelGGL(mk_fwd, dim3(grid), dim3(NWAVES * 64), LDS_BYTES, stream, a);
#endif
    const hipError_t le = hipPeekAtLastError();
    if (le != hipSuccess) fprintf(stderr, "kernel_launch: launch failed: %s\n", hipGetErrorName(le));
}
```

```cpp
#include <hip/hip_runtime.h>
#include <cstdio>
#include <cstdint>

#define GAS __attribute__((address_space(1)))
#define LAS __attribute__((address_space(3)))
typedef unsigned short bf16;
typedef short bf16x8 __attribute__((ext_vector_type(8)));
typedef float f32x4 __attribute__((ext_vector_type(4)));
typedef float f32x2 __attribute__((ext_vector_type(2)));
typedef unsigned u32x4 __attribute__((ext_vector_type(4)));
typedef unsigned u32x2 __attribute__((ext_vector_type(2)));

#ifndef MK_PER_PHASE
#define MK_PER_PHASE 0
#endif
#ifndef FAST_MASK
#define FAST_MASK 0x7f
#endif
#ifndef CONV_P2
#define CONV_P2 6
#endif
#ifndef CONV_P9
#define CONV_P9 4
#endif
#ifndef CONV_P10
#define CONV_P10 5
#endif
#ifndef CONV_P15
#define CONV_P15 1
#endif
#ifndef W2_LATE
#define W2_LATE 4608
#endif
#ifndef W13_SPLIT
#define W13_SPLIT 24000
#endif
#ifndef PH_LIMIT
#define PH_LIMIT 18
#endif

constexpr int D = 2048, NB = 2, SEQ = 8192, NLAT = NB * SEQ, CTXL = 256, NCTX = NB * CTXL, NTOK0 = NLAT + NCTX;
constexpr int NH = 8, DKH = 256, DVH = 512, VD = 4096, RIN = 12288;
constexpr int NE = 64, NE1 = 65, ED = 512;
constexpr int MODW = 6 * D;
constexpr float ALPHA = 1.41421356237309515f, LN_EPS = 1e-5f, ROUTED_SCALE = 2.5f;
constexpr int CAP = 16896;
constexpr int NPANEL0 = NTOK0 / 256;
constexpr int NIDX = NPANEL0 * NH;
constexpr int NQK = 64 * NH;
constexpr int NPH = 18;

constexpr size_t MiB = 1u << 20;
constexpr size_t WS_CTL = 0, CTL_ZERO_BYTES = 1 * MiB;
constexpr size_t WS_MOD = 1 * MiB;
constexpr size_t WS_ROPE = 1 * MiB + 512 * 1024;
constexpr size_t WS_L2G = WS_ROPE + 128 * 1024;
constexpr size_t WS_RW = 2 * MiB;
constexpr size_t WS_TOKE = 4 * MiB, WS_TOKP = 5 * MiB;
constexpr size_t WS_ROWL = 6 * MiB, WS_SLOTG = 11 * MiB;
constexpr size_t WS_WIN = 16 * MiB, WS_WOUT = 64 * MiB, WS_WPOOL = 80 * MiB;
constexpr size_t WS_W13_0 = 82 * MiB, WS_W2_0 = 342 * MiB;
constexpr size_t WS_HB = 472 * MiB, WS_XL = 538 * MiB, WS_R1 = 670 * MiB, WS_S = 802 * MiB;
constexpr size_t WS_KR = WS_S, WS_KDTF = WS_S + 66 * MiB, WS_KDTB = WS_S + 132 * MiB, WS_PQ = WS_S + 198 * MiB, WS_VS = WS_S + 396 * MiB;
constexpr size_t WS_U = WS_S + 792 * MiB, WS_GS = WS_S + 1056 * MiB, WS_O = WS_U, WS_A2 = WS_S;
constexpr size_t WS_W13_1 = WS_S, WS_W2_1 = WS_S + 260 * MiB, WS_ACT = WS_S + 390 * MiB, WS_Y = WS_S + 556 * MiB;
constexpr size_t WS_END = 2048 * MiB;
static_assert(WS_GS + 132 * MiB <= WS_END && WS_Y + 658 * MiB <= WS_END && WS_ACT + 166 * MiB <= WS_Y, "ws map");
constexpr size_t PQ_E = 256 * 768, VS_E = 512 * 768, KR_E = 256 * 256, U_E = 512 * 256;
constexpr size_t W13_E = 1024 * 2048, W2_E = 2048 * 512;
constexpr int CW_CNT = 8192;
constexpr int CW_BAR = 4096;

constexpr int RING_BYTES = 131072;
constexpr int SCR_BYTES = 8 * 16640;
constexpr int LDSCTL_OFF = 136 * 1024;
constexpr int LDS_BYTES = 147456;
static_assert(SCR_BYTES <= LDSCTL_OFF, "lds");
constexpr int NWAVES = 8;

#define RLX_AGENT __ATOMIC_RELAXED, __HIP_MEMORY_SCOPE_AGENT
#define LDS_WAIT() asm volatile("s_waitcnt lgkmcnt(0)" ::: "memory")
#define VM_WAIT() asm volatile("s_waitcnt vmcnt(0)" ::: "memory")

__device__ __forceinline__ unsigned cvt_pk_bf16(float lo, float hi) { unsigned r; asm volatile("v_cvt_pk_bf16_f32 %0, %1, %2" : "=v"(r) : "v"(lo), "v"(hi)); return r; }
__device__ __forceinline__ unsigned f2bf(float f) { unsigned u = __builtin_bit_cast(unsigned, f); return (u + 0x7fffu + ((u >> 16) & 1u)) >> 16; }
__device__ __forceinline__ float bf2f(unsigned b) { return __builtin_bit_cast(float, b << 16); }
__device__ __forceinline__ u32x4 pack8(f32x4 a, f32x4 b) { u32x4 w; w.x = cvt_pk_bf16(a[0], a[1]); w.y = cvt_pk_bf16(a[2], a[3]); w.z = cvt_pk_bf16(b[0], b[1]); w.w = cvt_pk_bf16(b[2], b[3]); return w; }
__device__ __forceinline__ float silu_f(float x) { return x * __builtin_amdgcn_rcpf(1.0f + __expf(-x)); }
__device__ __forceinline__ float wave_sum(float v) {
#pragma unroll
    for (int o = 1; o < 64; o <<= 1) v += __shfl_xor(v, o);
    return v;
}
__device__ __forceinline__ float wave_max(float v) {
#pragma unroll
    for (int o = 1; o < 64; o <<= 1) v = fmaxf(v, __shfl_xor(v, o));
    return v;
}

#define XB_TMO      128
#define XB_XCNT(j)  (256  + 64 * (j))
#define XB_XSUB(j)  (1280 + 64 * (j))
#define XB_XGEN(j)  (2304 + 64 * (j))
#define XB_TOP      3328
#define XB_TOPGEN   3392
#define XCD_BAR_WORDS 3456
#define XB_SPIN_CAP (1u << 18)
__device__ __forceinline__ unsigned xb_ld(unsigned* p)              { return __hip_atomic_load(p, __ATOMIC_RELAXED, __HIP_MEMORY_SCOPE_AGENT); }
__device__ __forceinline__ unsigned xb_add(unsigned* p, unsigned v) { return __hip_atomic_fetch_add(p, v, __ATOMIC_RELAXED, __HIP_MEMORY_SCOPE_AGENT); }
__device__ __forceinline__ unsigned xb_xcc_id() { return (unsigned)__builtin_amdgcn_s_getreg((3 << 11) | 20) & 0xFu; }
#define XB_SPIN(cond, bar) do { unsigned _sp = 0; while (cond) { __builtin_amdgcn_s_sleep(1); \
    if ((++_sp & 255u) == 0u) { if (xb_ld(&(bar)[XB_TMO])) break; if (_sp > XB_SPIN_CAP) { atomicAdd(&(bar)[XB_TMO], 1u); break; } } } } while (0)
struct XcdBarrier { unsigned* bar; unsigned x; volatile LAS unsigned* st; };
__device__ __forceinline__ XcdBarrier xcd_barrier_post(unsigned* bar, volatile LAS unsigned* st) {
    XcdBarrier b; b.bar = bar; b.x = xb_xcc_id(); b.st = st;
    if (threadIdx.x == 0) (void)xb_add(&bar[XB_XCNT(b.x)], 1u);
    return b;
}
__device__ __forceinline__ void xcd_barrier_complete(unsigned* bar, unsigned x, unsigned& nloc, unsigned& nx) {
    const unsigned G = gridDim.x * gridDim.y * gridDim.z;
    unsigned sum, cnt, mine, sp = 0u;
    for (;;) {
        sum = 0u; cnt = 0u; mine = 0u;
#pragma unroll
        for (unsigned j = 0; j < 16; ++j) { const unsigned c = xb_ld(&bar[XB_XCNT(j)]); sum += c; cnt += (c > 0u) ? 1u : 0u; mine = (j == x) ? c : mine; }
        if (sum == G) break;
        __builtin_amdgcn_s_sleep(1);
        if ((++sp & 255u) == 0u) { if (xb_ld(&bar[XB_TMO])) break; if (sp > XB_SPIN_CAP) { atomicAdd(&bar[XB_TMO], 1u); break; } }
    }
    nloc = mine > 0u ? mine : 1u; nx = cnt > 0u ? cnt : 1u;
}
__device__ __forceinline__ void xcd_barrier(const XcdBarrier& b) {
    asm volatile("s_waitcnt vmcnt(0)" ::: "memory");
    __syncthreads();
    if (threadIdx.x == 0) {
        unsigned* bar = b.bar;
        __builtin_amdgcn_s_waitcnt(0);
        unsigned nloc = b.st[0], nx = b.st[1];
        if (nloc == 0u) { xcd_barrier_complete(bar, b.x, nloc, nx); b.st[0] = nloc; b.st[1] = nx; }
        const unsigned old = xb_add(&bar[XB_XSUB(b.x)], 1u);
        const unsigned gen = old / nloc;
        if (old + 1u == (gen + 1u) * nloc) {
            __builtin_amdgcn_fence(__ATOMIC_RELEASE, "agent");
            asm volatile("s_waitcnt vmcnt(0)" ::: "memory");
            const unsigned og = xb_add(&bar[XB_TOP], 1u);
            const unsigned tg = og / nx;
            if (og + 1u == (tg + 1u) * nx) xb_add(&bar[XB_TOPGEN], 1u);
            else XB_SPIN(xb_ld(&bar[XB_TOPGEN]) == tg, bar);
            __builtin_amdgcn_fence(__ATOMIC_ACQUIRE, "agent");
            xb_add(&bar[XB_XGEN(b.x)], 1u);
            asm volatile("s_waitcnt vmcnt(0)" ::: "memory");
        } else {
            XB_SPIN(xb_ld(&bar[XB_XGEN(b.x)]) == gen, bar);
            __builtin_amdgcn_fence(__ATOMIC_ACQUIRE, "agent");
            asm volatile("s_waitcnt vmcnt(0)" ::: "memory");
        }
    }
    __syncthreads();
}

namespace pg8 {
constexpr int BM = 256, BK = 64, HALF = 128, HTB = HALF * BK * 2, STAGE_BYTES = 8 * HTB;
__host__ __device__ __forceinline__ int lds_byte(int r, int c) { const int st = (r >> 4) * 2 + (c >> 5), rr = r & 15, cc = c & 31, ob = rr * 64 + cc * 2; return st * 1024 + (ob ^ (((ob >> 9) & 1) << 5)); }
__host__ __device__ __forceinline__ void stage_rc(int b, int& R, int& C) { const int st = b / 1024, sb = b % 1024, swz = sb ^ (((sb >> 9) & 1) << 5); R = (st >> 1) * 16 + swz / 64; C = (st & 1) * 32 + (swz % 64) / 2; }
__host__ __device__ __forceinline__ int perm32(int rho) { const int n = rho >> 4, i = rho & 15; return 8 * (i >> 2) + 4 * n + (i & 3); }

struct Unit { const char* a; const char* b; int pm, pn, x0, x1; };
struct Dims { int lda, ldb, K; };

template <class Epi, class Sched, bool GATHER>
__device__ __forceinline__ void gemm_simple(const Dims g, const Sched& S, const Epi& E) {
    const int tid = threadIdx.x, wid = __builtin_amdgcn_readfirstlane(tid >> 6), lane = tid & 63, wr = wid >> 2, wc = wid & 3, fr = lane & 15, fq = lane >> 4;
    Unit u;
    for (int ui = 0; S.next(ui, u); ++ui) {
        f32x4 acc[2][2][4][2];
#pragma unroll
        for (int a = 0; a < 2; ++a)
#pragma unroll
            for (int b = 0; b < 2; ++b)
#pragma unroll
                for (int m = 0; m < 4; ++m)
#pragma unroll
                    for (int n = 0; n < 2; ++n) acc[a][b][m][n] = (f32x4){0.f, 0.f, 0.f, 0.f};
        unsigned aoff[2][4], boff[2][2];
#pragma unroll
        for (int ai = 0; ai < 2; ++ai)
#pragma unroll
            for (int m = 0; m < 4; ++m) { const int R = 128 * ai + 64 * wr + 16 * m + fr; const int row = GATHER ? S.row_of(u, R) : R; aoff[ai][m] = ((unsigned)row * (unsigned)g.lda + (unsigned)fq * 8u) * 2u; }
#pragma unroll
        for (int bj = 0; bj < 2; ++bj)
#pragma unroll
            for (int n = 0; n < 2; ++n) { const int R = 128 * bj + 32 * wc + (Epi::PERM ? perm32(16 * n + fr) : 16 * n + fr); boff[bj][n] = ((unsigned)R * (unsigned)g.ldb + (unsigned)fq * 8u) * 2u; }
        for (int k = 0; k < g.K; k += 32) {
#pragma unroll
            for (int ai = 0; ai < 2; ++ai) {
                bf16x8 At[4];
#pragma unroll
                for (int m = 0; m < 4; ++m) At[m] = *(const bf16x8*)(u.a + aoff[ai][m] + (size_t)k * 2);
#pragma unroll
                for (int bj = 0; bj < 2; ++bj) {
                    bf16x8 Bt[2];
#pragma unroll
                    for (int n = 0; n < 2; ++n) Bt[n] = *(const bf16x8*)(u.b + boff[bj][n] + (size_t)k * 2);
#pragma unroll
                    for (int m = 0; m < 4; ++m)
#pragma unroll
                        for (int n = 0; n < 2; ++n) acc[ai][bj][m][n] = __builtin_amdgcn_mfma_f32_16x16x32_bf16(Bt[n], At[m], acc[ai][bj][m][n], 0, 0, 0);
                    asm volatile("" ::: "memory");
                }
            }
        }
        __syncthreads();
        { int fr2 = fr, fq2 = fq, wr2 = wr, wc2 = wc; asm volatile("" : "+v"(fr2), "+v"(fq2), "+s"(wr2), "+s"(wc2)); E(acc, u, wr2, wc2, fr2, fq2); }
    }
}

template <class Epi, class Sched, bool GATHER>
__device__ __forceinline__ void gemm_fast(LAS unsigned char* lds, const Dims g, const Sched& S, const Epi& E) {
    const int tid = threadIdx.x, wid = __builtin_amdgcn_readfirstlane(tid >> 6), lane = tid & 63, wr = wid >> 2, wc = wid & 3, fr = lane & 15, fq = lane >> 4;
    const int nt = g.K / BK;
    unsigned voffA[2][2], voffB[2];
#pragma unroll
    for (int i = 0; i < 2; ++i) { int R, C; stage_rc(tid * 16 + i * 8192, R, C); const int Rb = Epi::PERM ? ((R & ~31) + perm32(R & 31)) : R;
        voffA[0][i] = (unsigned)(R * g.lda + C) * 2u; voffA[1][i] = (unsigned)((R + HALF) * g.lda + C) * 2u; voffB[i] = (unsigned)(Rb * g.ldb + C) * 2u; }
    const size_t kstep = (size_t)(BK * 2);
    const size_t hstepB = (size_t)HALF * g.ldb * 2;
    const unsigned ldsw = (unsigned)wid * 1024u;
    const int aoff = lds_byte(wr * 64 + fr, fq * 8), boff = lds_byte(wc * 32 + fr, fq * 8);
#define PG8_SA(b, h) (((b) * 2 + (h)) * HTB)
#define PG8_SB(b, h) ((4 + (b) * 2 + (h)) * HTB)
#define PG8_STAGEA(bufoff, gbase, h) do { _Pragma("unroll") for (int _i = 0; _i < 2; ++_i) \
        __builtin_amdgcn_global_load_lds((const unsigned*)((const char*)(gbase) + voffA[h][_i]), (LAS unsigned*)(lds + (bufoff) + ldsw + _i * 8192), 16, 0, 0); } while (0)
#define PG8_STAGEB(bufoff, gbase) do { _Pragma("unroll") for (int _i = 0; _i < 2; ++_i) \
        __builtin_amdgcn_global_load_lds((const unsigned*)((const char*)(gbase) + voffB[_i]), (LAS unsigned*)(lds + (bufoff) + ldsw + _i * 8192), 16, 0, 0); } while (0)
#define PG8_LDA(dst, b, h) do { _Pragma("unroll") for (int m = 0; m < 4; ++m) _Pragma("unroll") for (int k = 0; k < 2; ++k) dst[m][k] = *(const LAS bf16x8*)(lds + PG8_SA(b, h) + aoff + m * 2048 + k * 1024); } while (0)
#define PG8_LDB(dst, b, h) do { _Pragma("unroll") for (int n = 0; n < 2; ++n) _Pragma("unroll") for (int k = 0; k < 2; ++k) dst[n][k] = *(const LAS bf16x8*)(lds + PG8_SB(b, h) + boff + n * 2048 + k * 1024); } while (0)
#define PG8_MMA(ai, bj, At, Bt) do { __builtin_amdgcn_s_setprio(1); _Pragma("unroll") for (int m = 0; m < 4; ++m) _Pragma("unroll") for (int n = 0; n < 2; ++n) _Pragma("unroll") for (int k = 0; k < 2; ++k) \
        acc[ai][bj][m][n] = __builtin_amdgcn_mfma_f32_16x16x32_bf16(Bt[n][k], At[m][k], acc[ai][bj][m][n], 0, 0, 0); __builtin_amdgcn_s_setprio(0); } while (0)
#define PG8_WAIT_V(n) asm volatile("s_waitcnt vmcnt(" #n ")" ::: "memory")
#define PG8_WAIT_L(n) asm volatile("s_waitcnt lgkmcnt(" #n ")" ::: "memory")
#define PG8_BAR __builtin_amdgcn_s_barrier()
#define PG8_SCHED __builtin_amdgcn_sched_barrier(0)
#define PG8_GOFF(uu) do { if constexpr (GATHER) { _Pragma("unroll") for (int _i = 0; _i < 2; ++_i) { int _R, _C; stage_rc((int)threadIdx.x * 16 + _i * 8192, _R, _C); _Pragma("unroll") for (int _h = 0; _h < 2; ++_h) \
        voffA[_h][_i] = ((unsigned)S.row_of(uu, _R + _h * HALF) * (unsigned)g.lda + (unsigned)_C) * 2u; } } } while (0)
    Unit cur, nxt; int ui = 0;
    if (!S.next(0, cur)) return;
    f32x4 acc[2][2][4][2];
#pragma unroll
    for (int a = 0; a < 2; ++a)
#pragma unroll
        for (int b = 0; b < 2; ++b)
#pragma unroll
            for (int m = 0; m < 4; ++m)
#pragma unroll
                for (int n = 0; n < 2; ++n) acc[a][b][m][n] = (f32x4){0.f, 0.f, 0.f, 0.f};
    bf16x8 At[4][2], B0[2][2], B1[2][2];
    const char* cA = cur.a; const char* cB = cur.b;
    PG8_GOFF(cur);
    PG8_STAGEB(PG8_SB(0, 0), cB); PG8_STAGEB(PG8_SB(0, 1), cB + hstepB); PG8_STAGEA(PG8_SA(0, 0), cA, 0); PG8_STAGEA(PG8_SA(0, 1), cA, 1);
    if (wr == 1) PG8_BAR;
    PG8_WAIT_V(2); PG8_BAR;
    PG8_STAGEB(PG8_SB(1, 0), cB + kstep); PG8_STAGEA(PG8_SA(1, 0), cA + kstep, 0); PG8_STAGEB(PG8_SB(1, 1), cB + hstepB + kstep);
    PG8_WAIT_V(6); PG8_BAR;
    for (;;) {
        const bool has_next = S.next(ui + 1, nxt);
        const char* nA = has_next ? nxt.a : cA; const char* nB = has_next ? nxt.b : cB;
        for (int t = 0; t < nt; t += 2) {
            const bool last = (t == nt - 2);
            const char* a1 = cA + (size_t)(t + 1) * kstep;
            const char* a2 = last ? nA : cA + (size_t)(t + 2) * kstep; const char* b2 = last ? nB : cB + (size_t)(t + 2) * kstep;
            const char* a3 = a2 + kstep; const char* b3 = b2 + kstep;
            PG8_LDB(B0, 0, 0); PG8_LDB(B1, 0, 1); PG8_SCHED; PG8_LDA(At, 0, 0); PG8_STAGEA(PG8_SA(1, 1), a1, 1);
            if (last && has_next) PG8_GOFF(nxt);
            PG8_WAIT_V(8); PG8_WAIT_L(0); PG8_BAR; PG8_MMA(0, 0, At, B0); PG8_MMA(0, 1, At, B1); PG8_BAR; PG8_SCHED;
            PG8_LDA(At, 0, 1); PG8_STAGEB(PG8_SB(0, 0), b2); PG8_STAGEB(PG8_SB(0, 1), b2 + hstepB); PG8_STAGEA(PG8_SA(0, 0), a2, 0);
            PG8_WAIT_V(8); PG8_WAIT_L(0); PG8_BAR; PG8_MMA(1, 0, At, B0); PG8_MMA(1, 1, At, B1); PG8_BAR; PG8_SCHED;
            PG8_LDB(B0, 1, 0); PG8_LDB(B1, 1, 1); PG8_SCHED; PG8_LDA(At, 1, 0); PG8_STAGEA(PG8_SA(0, 1), a2, 1);
            PG8_WAIT_V(8); PG8_WAIT_L(0); PG8_BAR; PG8_MMA(0, 0, At, B0); PG8_MMA(0, 1, At, B1); PG8_BAR; PG8_SCHED;
            PG8_LDA(At, 1, 1); PG8_STAGEB(PG8_SB(1, 0), b3); PG8_STAGEB(PG8_SB(1, 1), b3 + hstepB); PG8_STAGEA(PG8_SA(1, 0), a3, 0);
            PG8_WAIT_V(8); PG8_WAIT_L(0); PG8_BAR; PG8_MMA(1, 0, At, B0); PG8_MMA(1, 1, At, B1); PG8_BAR; PG8_SCHED;
        }
        if (wr == 0) PG8_BAR;
        { int fr2 = fr, fq2 = fq, wr2 = wr, wc2 = wc; asm volatile("" : "+v"(fr2), "+v"(fq2), "+s"(wr2), "+s"(wc2)); E(acc, cur, wr2, wc2, fr2, fq2); }
        if (!has_next) break;
#pragma unroll
        for (int a = 0; a < 2; ++a)
#pragma unroll
            for (int b = 0; b < 2; ++b)
#pragma unroll
                for (int m = 0; m < 4; ++m)
#pragma unroll
                    for (int n = 0; n < 2; ++n) acc[a][b][m][n] = (f32x4){0.f, 0.f, 0.f, 0.f};
        cur = nxt; cA = nA; cB = nB; ++ui;
        if (wr == 1) PG8_BAR;
    }
    PG8_WAIT_V(0);
    PG8_BAR;
#undef PG8_SA
#undef PG8_SB
#undef PG8_STAGEA
#undef PG8_STAGEB
#undef PG8_LDA
#undef PG8_LDB
#undef PG8_MMA
#undef PG8_WAIT_V
#undef PG8_WAIT_L
#undef PG8_BAR
#undef PG8_SCHED
#undef PG8_GOFF
}
}
using pg8::Unit;
using pg8::Dims;

template <int SITE, class Epi, class Sched, bool GATHER = false>
__device__ __forceinline__ void gemm_run(LAS unsigned char* lds, const Dims g, const Sched& S, const Epi& E) {
    if constexpr (((FAST_MASK) >> SITE) & 1) pg8::gemm_fast<Epi, Sched, GATHER>(lds, g, S, E);
    else pg8::gemm_simple<Epi, Sched, GATHER>(g, S, E);
}

struct Frame {
    LAS unsigned char* lds;
    volatile LAS unsigned* MISC;
    LAS int* TAB;
    unsigned* ctl;
    unsigned char* ws;
    int tid, lane, wave, vcu, G;
    float* out;
};
constexpr int NXCD = 8, WGM = 8;

struct SchedDense {
    const char* A; const char* Bt; int lda, ldb, nM, nN, nwg, G, c;
    __device__ __forceinline__ bool next(int i, Unit& u) const {
        const long L = (long)i * G + c; if (L >= nwg) return false;
        int wgid = (int)L; { const int q = nwg / NXCD, r = nwg % NXCD, xcd = wgid % NXCD, off = wgid / NXCD; wgid = (xcd < r ? xcd * (q + 1) : r * (q + 1) + (xcd - r) * q) + off; }
        const int nig = WGM * nN, gid = wgid / nig, fm = gid * WGM, gsz = (nM - fm) < WGM ? (nM - fm) : WGM;
        u.pm = fm + ((wgid % nig) % gsz); u.pn = (wgid % nig) / gsz; u.x0 = 0; u.x1 = 0;
        u.a = A + (size_t)u.pm * 256 * lda * 2; u.b = Bt + (size_t)u.pn * 256 * ldb * 2; return true;
    }
    __device__ __forceinline__ int row_of(const Unit&, int R) const { return R; }
};
struct SchedRet3 {
    const char* PQ; const char* KR; const char* VS; const char* KDT; size_t kdt_dir_stride; int G, vcu;
    __device__ __forceinline__ bool next(int i, Unit& u) const {
        const int L = i * G + vcu; if (L >= NQK + 2048) return false;
        if (L < NQK) { u.pm = L; u.x0 = 0; u.x1 = 0; u.pn = 0; u.a = PQ + ((size_t)L * PQ_E + 256) * 2; u.b = KR + (size_t)L * KR_E * 2; }
        else { const int j = L - NQK; int panel, h, dir; const int half = j & 1;
            if (j < 1984) { const int pq = j >> 5; h = (j >> 2) & 7; dir = (j >> 1) & 1; panel = pq < 60 ? (pq >= 30 ? 3 : 1) + pq : 4 + pq; }
            else { const int k = j - 1984, w = k >> 4; h = (k >> 1) & 7; dir = w & 1; panel = (w >> 1) * 32 + (w & 1) * 31; }
            const int idx = panel * 8 + h; u.pm = idx; u.x0 = 1; u.x1 = dir * 2 + half; u.pn = 0;
            u.a = VS + ((size_t)idx * VS_E + (size_t)half * 256 * 768) * 2; u.b = KDT + (size_t)dir * kdt_dir_stride + (size_t)idx * KR_E * 2; }
        return true;
    }
    __device__ __forceinline__ int row_of(const Unit&, int R) const { return R; }
};
struct SchedO {
    const char* PQ; const char* VS; int G, vcu;
    __device__ __forceinline__ bool next(int i, Unit& u) const {
        const int L = i * G + vcu; if (L >= NQK * 2) return false;
        const int idx = L >> 1, half = L & 1; u.pm = idx; u.pn = half; u.x0 = 0; u.x1 = 0;
        u.a = PQ + (size_t)idx * PQ_E * 2; u.b = VS + ((size_t)idx * VS_E + (size_t)half * 256 * 768) * 2; return true;
    }
    __device__ __forceinline__ int row_of(const Unit&, int R) const { return R; }
};
struct SchedPool {
    const char* P; const char* W; int G, vcu;
    __device__ __forceinline__ bool next(int i, Unit& u) const {
        const int L = i * G + vcu; if (L >= 64 * 8) return false;
        const int pm = L >> 3, g = (L >> 1) & 3, half = L & 1; u.pm = pm; u.pn = g * 512 + half * 256; u.x0 = 0; u.x1 = 0;
        u.a = P + ((size_t)pm * 256 * D + (size_t)g * 512) * 2; u.b = W + ((size_t)g * 512 + (size_t)half * 256) * 512 * 2; return true;
    }
    __device__ __forceinline__ int row_of(const Unit&, int R) const { return R; }
};
struct SchedMoE {
    const LAS int* TAB; const char* A; const char* W; const int* rowl; int NT  , lda_bytes_per_row, G, vcu, gather; size_t wstride  , wtile  ;
    __device__ __forceinline__ bool next(int i, Unit& u) const {
        const int L = i * G + vcu; const int total = TAB[65];
        if (L >= total * NT) return false;
        const int pg = L / NT, pn = L - pg * NT;
        const int lane = threadIdx.x & 63;
        const int t1 = TAB[lane + 1];
        const int e = __builtin_popcountll(__ballot(t1 <= pg));
        const int panel = pg - TAB[e];
        u.pm = pg * 256; u.pn = pn; u.x0 = e; u.x1 = panel * 256;
        u.a = gather ? A : A + (size_t)pg * 256 * lda_bytes_per_row;
        u.b = W + (size_t)e * wstride + (size_t)pn * wtile; return true;
    }
    __device__ __forceinline__ int row_of(const Unit& u, int R) const {
        const int s = u.x1 + R;
        if (u.x0 == NE) return s;
        return (s < TAB[66 + u.x0]) ? rowl[(size_t)u.x0 * CAP + s] : 0;
    }
    __device__ __forceinline__ const int* row_ptr(const Unit& u, int R) const { const int e = u.x0 < NE ? u.x0 : 0; return rowl + (size_t)e * CAP + (u.x1 + R); }
    __device__ __forceinline__ int row_fix(const Unit& u, int R, int loaded) const {
        const int s = u.x1 + R;
        if (u.x0 == NE) return s;
        return (s < TAB[66 + u.x0]) ? loaded : 0;
    }
};


struct SchedWin {
    const char* HBp; const char* W; int G, vcu;
    __device__ __forceinline__ bool next(int i, Unit& u) const {
        const int L = i * G + vcu; if (L >= 2064 + 1056) return false;
        if (L < 2064) {
            int pm, pn;
            if (L < 2048) { const int gid = L >> 8, r = L & 255, t32 = r >> 3; pm = gid * 8 + (r & 7); pn = t32 < 16 ? t32 : t32 + 16; }
            else { const int j = L - 2048; pm = 64 + (j >> 3); pn = 8 + (j & 7); }
            u.pm = pm; u.pn = pn; u.x0 = 0; u.x1 = 0;
            u.a = HBp + (size_t)pm * 256 * D * 2; u.b = W + (size_t)pn * 256 * D * 2;
        } else {
            const int j = L - 2064, pm = j >> 4, rt = j & 15;
            u.pm = pm; u.pn = rt; u.x0 = 1; u.x1 = 0;
            u.a = W + (size_t)(4096 + 256 * rt) * D * 2; u.b = HBp + (size_t)pm * 256 * D * 2;
        }
        return true;
    }
    __device__ __forceinline__ int row_of(const Unit&, int R) const { return R; }
};
struct EpiWin {
    static constexpr bool PERM = true;
    bf16 *Kr, *Kdtf, *Kdtb, *PQ, *VS, *Gs; const float *ropeR, *ropeC, *l2f, *l2b;
    __device__ __forceinline__ void operator()(const f32x4 (&acc)[2][2][4][2], const Unit& u, int wr, int wc, int fr, int fq) const {
        const int pm = u.pm, pn = u.pn;
        if (u.x0 == 1) {
            const int h = pn >> 1, half = pn & 1, idx = pm * 8 + h;
#pragma unroll
            for (int ai = 0; ai < 2; ++ai)
#pragma unroll
                for (int m = 0; m < 4; ++m) {
                    const int dv = half * 256 + 128 * ai + 64 * wr + 16 * m + fr;
#pragma unroll
                    for (int bj = 0; bj < 2; ++bj)
                        *(u32x4*)(VS + (size_t)idx * VS_E + (size_t)dv * 768 + 128 * bj + 32 * wc + 8 * fq) = pack8(acc[ai][bj][m][0], acc[ai][bj][m][1]);
                }
            return;
        }
        if (pn < 16) {
            const int h = pn & 7; const bool isK = pn >= 8; const int idx = pm * 8 + h;
            const bool lat = pm < 64; const int pos0 = (pm & 31) * 256;
            const float lf = l2f[h], lb = l2b[h];
            const int i0 = 16 * wc + 4 * fq;
            f32x4 cR[2][2], cC[4][2];
#pragma unroll
            for (int ai = 0; ai < 2; ++ai) { const float* tab = ropeR + (size_t)((pos0 >> 6) + 2 * ai + wr) * 128 + 2 * i0; cR[ai][0] = *(const f32x4*)(tab); cR[ai][1] = *(const f32x4*)(tab + 4); }
#pragma unroll
            for (int m = 0; m < 4; ++m) { const float* tab = ropeC + (size_t)(16 * m + fr) * 128 + 2 * i0; cC[m][0] = *(const f32x4*)(tab); cC[m][1] = *(const f32x4*)(tab + 4); }
#pragma unroll
            for (int ai = 0; ai < 2; ++ai)
#pragma unroll
                for (int m = 0; m < 4; ++m) {
                    const int p = 128 * ai + 64 * wr + 16 * m + fr;
                    const float d1 = isK ? __builtin_amdgcn_exp2f(lf * (float)(255 - p)) * 0.0625f : __builtin_amdgcn_exp2f(lf * (float)(p + 1));
                    const float d2 = isK ? __builtin_amdgcn_exp2f(lb * (float)p) * 0.0625f : __builtin_amdgcn_exp2f(lb * (float)(256 - p));
#pragma unroll
                    for (int bj = 0; bj < 2; ++bj) {
                        const int dk0 = 128 * bj + 32 * wc + 8 * fq;
                        f32x4 v0 = acc[ai][bj][m][0], v1 = acc[ai][bj][m][1];
                        if (lat) {
                            const f32x4 c0 = (bj == 0) ? cR[ai][0] : cC[m][0], c1 = (bj == 0) ? cR[ai][1] : cC[m][1];
                            f32x4 r0, r1;
                            r0[0] = v0[0] * c0[0] - v0[1] * c0[1]; r0[1] = v0[0] * c0[1] + v0[1] * c0[0];
                            r0[2] = v0[2] * c0[2] - v0[3] * c0[3]; r0[3] = v0[2] * c0[3] + v0[3] * c0[2];
                            r1[0] = v1[0] * c1[0] - v1[1] * c1[1]; r1[1] = v1[0] * c1[1] + v1[1] * c1[0];
                            r1[2] = v1[2] * c1[2] - v1[3] * c1[3]; r1[3] = v1[2] * c1[3] + v1[3] * c1[2];
                            v0 = r0; v1 = r1;
                        }
                        if (!isK) {
                            bf16* row = PQ + (size_t)idx * PQ_E + (size_t)p * 768 + dk0;
                            *(u32x4*)(row + 256) = pack8(v0 * d1, v1 * d1);
                            *(u32x4*)(row + 512) = pack8(v0 * d2, v1 * d2);
                        } else {
                            *(u32x4*)(Kr + (size_t)idx * KR_E + (size_t)p * 256 + dk0) = pack8(v0 * 0.0625f, v1 * 0.0625f);
                            bf16* tf = Kdtf + (size_t)idx * KR_E + (size_t)dk0 * 256 + p;
                            bf16* tb = Kdtb + (size_t)idx * KR_E + (size_t)dk0 * 256 + p;
#pragma unroll
                            for (int j = 0; j < 4; ++j) {
                                const unsigned pf = cvt_pk_bf16(v0[j] * d1, v1[j] * d1), pb = cvt_pk_bf16(v0[j] * d2, v1[j] * d2);
                                tf[(size_t)j * 256] = (bf16)(pf & 0xffffu); tf[(size_t)(4 + j) * 256] = (bf16)(pf >> 16);
                                tb[(size_t)j * 256] = (bf16)(pb & 0xffffu); tb[(size_t)(4 + j) * 256] = (bf16)(pb >> 16);
                            }
                        }
                    }
                }
        } else {
            const int gc0 = (pn - 32) * 256;
#pragma unroll
            for (int ai = 0; ai < 2; ++ai)
#pragma unroll
                for (int m = 0; m < 4; ++m) {
                    const int r = 256 * pm + 128 * ai + 64 * wr + 16 * m + fr;
#pragma unroll
                    for (int bj = 0; bj < 2; ++bj) {
                        const int c = gc0 + 128 * bj + 32 * wc + 8 * fq;
                        f32x4 v0 = acc[ai][bj][m][0], v1 = acc[ai][bj][m][1];
                        *(u32x4*)(Gs + (size_t)r * VD + c) = pack8(v0, v1);
                        asm volatile("" ::: "memory");
                    }
                }
        }
    }
};
struct EpiRet3 {
    static constexpr bool PERM = true;
    bf16 *PQ, *U; const float *l2f, *l2b;
    __device__ __forceinline__ void operator()(const f32x4 (&acc)[2][2][4][2], const Unit& u, int wr, int wc, int fr, int fq) const {
        const int idx = u.pm;
        if (u.x0 == 0) {
            const int h = idx & 7; const float lf = l2f[h], lb = l2b[h];
#pragma unroll
            for (int ai = 0; ai < 2; ++ai)
#pragma unroll
                for (int m = 0; m < 4; ++m) {
                    const int p = 128 * ai + 64 * wr + 16 * m + fr;
#pragma unroll
                    for (int bj = 0; bj < 2; ++bj) {
                        const int c0 = 128 * bj + 32 * wc + 8 * fq;
                        u32x4 w;
#pragma unroll
                        for (int n = 0; n < 2; ++n) {
                            f32x4 v = acc[ai][bj][m][n];
#pragma unroll
                            for (int j = 0; j < 4; ++j) { const int cc = c0 + 4 * n + j, d = p - cc;
                                v[j] *= __builtin_amdgcn_exp2f(d >= 0 ? -lf * (float)(cc + 1) : lb * (float)(-d) - lf * (float)(p + 1)); }
                            const unsigned q0 = cvt_pk_bf16(v[0], v[1]), q1 = cvt_pk_bf16(v[2], v[3]);
                            if (n == 0) { w.x = q0; w.y = q1; } else { w.z = q0; w.w = q1; }
                        }
                        *(u32x4*)(PQ + (size_t)idx * PQ_E + (size_t)p * 768 + c0) = w;
                        asm volatile("" ::: "memory");
                    }
                }
        } else {
            const int dir = u.x1 >> 1, half = u.x1 & 1;
            bf16* base = U + ((size_t)idx * 2 + dir) * U_E;
#pragma unroll
            for (int ai = 0; ai < 2; ++ai)
#pragma unroll
                for (int m = 0; m < 4; ++m) {
                    const int dv = half * 256 + 128 * ai + 64 * wr + 16 * m + fr;
#pragma unroll
                    for (int bj = 0; bj < 2; ++bj) {
                        const int c0 = 128 * bj + 32 * wc + 8 * fq;
                        *(u32x4*)(base + (size_t)dv * 256 + c0) = pack8(acc[ai][bj][m][0], acc[ai][bj][m][1]);
                        asm volatile("" ::: "memory");
                    }
                }
        }
    }
};
struct EpiO {
    static constexpr bool PERM = true;
    bf16* O;
    __device__ __forceinline__ void operator()(const f32x4 (&acc)[2][2][4][2], const Unit& u, int wr, int wc, int fr, int fq) const {
        const int pm = u.pm >> 3, h = u.pm & 7, cb = h * 512 + u.pn * 256;
#pragma unroll
        for (int ai = 0; ai < 2; ++ai)
#pragma unroll
            for (int m = 0; m < 4; ++m) {
                const int r = 256 * pm + 128 * ai + 64 * wr + 16 * m + fr;
#pragma unroll
                for (int bj = 0; bj < 2; ++bj)
                    *(u32x4*)(O + (size_t)r * VD + cb + 128 * bj + 32 * wc + 8 * fq) = pack8(acc[ai][bj][m][0], acc[ai][bj][m][1]);
            }
    }
};
struct EpiResid {
    static constexpr bool PERM = false;
    float* R1; const float* xa; const float* xb; int nsplit; const float* gate; const float* cscale; int has_scale;
    __device__ __forceinline__ void operator()(const f32x4 (&acc)[2][2][4][2], const Unit& u, int wr, int wc, int fr, int fq) const {
        const int cb = u.pn * (has_scale ? 1 : 256);
        const int r0 = 256 * u.pm;
        const int v = (r0 < NLAT) ? (r0 >> 13) : 2;
        const float* gr = gate + (size_t)v * MODW;
        f32x4 gv[2][2];
#pragma unroll
        for (int bj = 0; bj < 2; ++bj)
#pragma unroll
            for (int n = 0; n < 2; ++n) { const int c = cb + 128 * bj + 32 * wc + 16 * n + 4 * fq; gv[bj][n] = *(const f32x4*)(gr + c); if (has_scale) gv[bj][n] = gv[bj][n] * *(const f32x4*)(cscale + c); }
#pragma unroll
        for (int ai = 0; ai < 2; ++ai) {
            f32x4 xv[4][2][2];
#pragma unroll
            for (int m = 0; m < 4; ++m) {
                const int r = r0 + 128 * ai + 64 * wr + 16 * m + fr;
                const float* xr = (r < nsplit) ? xa + (size_t)r * D : xb + (size_t)(r - nsplit) * D;
#pragma unroll
                for (int bj = 0; bj < 2; ++bj)
#pragma unroll
                    for (int n = 0; n < 2; ++n) xv[m][bj][n] = *(const f32x4*)(xr + cb + 128 * bj + 32 * wc + 16 * n + 4 * fq);
            }
#pragma unroll
            for (int m = 0; m < 4; ++m) {
                const int r = r0 + 128 * ai + 64 * wr + 16 * m + fr;
#pragma unroll
                for (int bj = 0; bj < 2; ++bj)
#pragma unroll
                    for (int n = 0; n < 2; ++n) *(f32x4*)(R1 + (size_t)r * D + cb + 128 * bj + 32 * wc + 16 * n + 4 * fq) = xv[m][bj][n] * ALPHA + gv[bj][n] * acc[ai][bj][m][n];
            }
        }
    }
};
struct EpiMoe1 {
    static constexpr bool PERM = true;
    bf16* ACT;
    __device__ __forceinline__ void operator()(const f32x4 (&acc)[2][2][4][2], const Unit& u, int wr, int wc, int fr, int fq) const {
#pragma unroll
        for (int ai = 0; ai < 2; ++ai)
#pragma unroll
            for (int m = 0; m < 4; ++m) {
                const int r = u.pm + 128 * ai + 64 * wr + 16 * m + fr;
                f32x4 v0, v1;
#pragma unroll
                for (int j = 0; j < 4; ++j) { v0[j] = silu_f(acc[ai][0][m][0][j]) * acc[ai][1][m][0][j]; v1[j] = silu_f(acc[ai][0][m][1][j]) * acc[ai][1][m][1][j]; }
                *(u32x4*)(ACT + (size_t)r * ED + u.pn * 128 + 32 * wc + 8 * fq) = pack8(v0, v1);
            }
    }
};
constexpr float Y_SCALE = 64.0f;
struct EpiMoe2 {
    static constexpr bool PERM = true;
    unsigned char* Y;
    __device__ __forceinline__ void operator()(const f32x4 (&acc)[2][2][4][2], const Unit& u, int wr, int wc, int fr, int fq) const {
#pragma unroll
        for (int ai = 0; ai < 2; ++ai)
#pragma unroll
            for (int m = 0; m < 4; ++m) {
                const int p = 128 * ai + 64 * wr + 16 * m + fr;
#pragma unroll
                for (int bj = 0; bj < 2; ++bj) {
                    f32x4 v0 = acc[ai][bj][m][0], v1 = acc[ai][bj][m][1];
#pragma unroll
                    for (int j = 0; j < 4; ++j) { v0[j] = __builtin_amdgcn_fmed3f(v0[j], -448.0f, 448.0f); v1[j] = __builtin_amdgcn_fmed3f(v1[j], -448.0f, 448.0f); }
                    int w0 = 0, w1 = 0;
                    w0 = __builtin_amdgcn_cvt_pk_fp8_f32(v0[0], v0[1], w0, false); w0 = __builtin_amdgcn_cvt_pk_fp8_f32(v0[2], v0[3], w0, true);
                    w1 = __builtin_amdgcn_cvt_pk_fp8_f32(v1[0], v1[1], w1, false); w1 = __builtin_amdgcn_cvt_pk_fp8_f32(v1[2], v1[3], w1, true);
                    u32x2 w; w.x = (unsigned)w0; w.y = (unsigned)w1;
                    *(u32x2*)(Y + (size_t)(u.pm + p) * D + 256 * u.pn + 128 * bj + 32 * wc + 8 * fq) = w;
                }
            }
    }
};

struct ConvJob { const float* src; bf16* dst; int ldw, ldt; float scale; };
__device__ __forceinline__ void conv_load(const ConvJob& j, f32x4 (&v)[16], int lane) {
    const float* src = j.src + (size_t)(lane >> 4) * j.ldw + (lane & 15) * 4;
#pragma unroll
    for (int i = 0; i < 16; ++i) v[i] = *(const f32x4*)(src + (size_t)(4 * i) * j.ldw);
}
__device__ __forceinline__ void conv_store(const ConvJob& j, const f32x4 (&v)[16], LAS float* scr, int lane) {
#pragma unroll
    for (int i = 0; i < 16; ++i) { LAS float* s = scr + (4 * i + (lane >> 4)) * 65 + (lane & 15) * 4; s[0] = v[i][0]; s[1] = v[i][1]; s[2] = v[i][2]; s[3] = v[i][3]; }
    LDS_WAIT(); asm volatile("" ::: "memory");
    const int c = lane & 7;
#pragma unroll
    for (int q = 0; q < 8; ++q) {
        const int n = (lane >> 3) + 8 * q; const LAS float* s = scr + (8 * c) * 65 + n;
        const float sc_ = j.scale;
        u32x4 o; o.x = cvt_pk_bf16(s[0 * 65] * sc_, s[1 * 65] * sc_); o.y = cvt_pk_bf16(s[2 * 65] * sc_, s[3 * 65] * sc_); o.z = cvt_pk_bf16(s[4 * 65] * sc_, s[5 * 65] * sc_); o.w = cvt_pk_bf16(s[6 * 65] * sc_, s[7 * 65] * sc_);
        *(u32x4*)(j.dst + (size_t)n * j.ldt + 8 * c) = o;
    }
    LDS_WAIT(); asm volatile("" ::: "memory");
}
struct JobP0 {
    const float *win, *wout, *wpool; bf16 *WINd, *WOUTd, *WPOOLd;
    static constexpr int N = 32 * 192 + 64 * 32 + 4 * 64;
    __device__ __forceinline__ ConvJob operator()(int r) const {
        ConvJob j; j.scale = 1.0f;
        if (r < 32 * 192) { const int kb = r / 192, nb = r % 192; j.src = win + (size_t)kb * 64 * RIN + nb * 64; j.ldw = RIN; j.dst = WINd + (size_t)nb * 64 * D + kb * 64; j.ldt = D; return j; }
        r -= 32 * 192;
        if (r < 64 * 32) { const int kb = r / 32, nb = r % 32; j.src = wout + (size_t)kb * 64 * D + nb * 64; j.ldw = D; j.dst = WOUTd + (size_t)nb * 64 * VD + kb * 64; j.ldt = VD; return j; }
        r -= 64 * 32;
        { const int g = r >> 6, t = r & 63, kb = t >> 3, nb = t & 7; j.src = wpool + (size_t)g * 512 * 512 + (size_t)kb * 64 * 512 + nb * 64; j.ldw = 512; j.dst = WPOOLd + (size_t)g * 512 * 512 + (size_t)nb * 64 * 512 + kb * 64; j.ldt = 512; return j; }
    }
};
struct JobExp {
    const float *eg, *eu, *ed, *sg, *su, *sd; bf16 *W13, *W2; int layer, mode;
    __device__ __forceinline__ int count() const { return NE1 * (mode == 0 ? 512 : mode == 1 ? 256 : 768); }
    __device__ __forceinline__ ConvJob operator()(int it) const {
        const int per = (mode == 0 ? 512 : mode == 1 ? 256 : 768);
        const int e = it / per; int r = it - e * per; if (mode == 1) r += 512;
        const int mat = r >> 8, t = r & 255;
        ConvJob j; j.scale = (mat < 2) ? 1.0f : 64.0f;
        if (mat < 2) {
            const float* We = mat ? eu : eg; const float* Ws = mat ? su : sg;
            const float* W = (e < NE) ? We + ((size_t)layer * NE + e) * (size_t)(D * ED) : Ws + (size_t)layer * (D * ED);
            const int kb = t >> 3, n0 = (t & 7) * 64;
            j.src = W + (size_t)kb * 64 * ED + n0; j.ldw = ED;
            j.dst = W13 + (size_t)e * W13_E + (size_t)((n0 >> 7) * 256 + (n0 & 127) + mat * 128) * D + kb * 64; j.ldt = D;
        } else {
            const float* W = (e < NE) ? ed + ((size_t)layer * NE + e) * (size_t)(ED * D) : sd + (size_t)layer * (ED * D);
            const int kb = t >> 5, nb = t & 31;
            j.src = W + (size_t)kb * 64 * D + nb * 64; j.ldw = D;
            j.dst = W2 + (size_t)e * W2_E + (size_t)nb * 64 * ED + kb * 64; j.ldt = ED;
        }
        return j;
    }
};
struct JobTail {
    JobExp a, b; int from;
    __device__ __forceinline__ int count() const { return (a.count() - from) + b.count(); }
    __device__ __forceinline__ ConvJob operator()(int it) const { const int na = a.count() - from; return it < na ? a(from + it) : b(it - na); }
};
struct JobFrom {
    JobExp b; int from;
    __device__ __forceinline__ int count() const { return b.count() - from; }
    __device__ __forceinline__ ConvJob operator()(int it) const { return b(from + it); }
};
template <class Dec>
__device__ __forceinline__ void conv_loop(const Dec& dec, int first, int stride, int n, LAS float* scr, int lane) {
    for (int it = first; it < n; it += 3 * stride) {
        const bool h1 = it + stride < n, h2 = it + 2 * stride < n;
        const ConvJob j0 = dec(it); ConvJob j1 = j0, j2 = j0;
        f32x4 v0[16], v1[16], v2[16];
        conv_load(j0, v0, lane);
        if (h1) { j1 = dec(it + stride); conv_load(j1, v1, lane); }
        if (h2) { j2 = dec(it + 2 * stride); conv_load(j2, v2, lane); }
        conv_store(j0, v0, scr, lane);
        if (h1) conv_store(j1, v1, scr, lane);
        if (h2) conv_store(j2, v2, scr, lane);
    }
}
struct Roles { int is_conv, g_rank, g_count, c_rank, c_count; };
__device__ __forceinline__ Roles make_roles(const Frame& F, int nper) {
    Roles r; const int per = F.G / 8, bx = blockIdx.x, x = bx % 8, rix = bx / 8;
    if (F.G % 8 != 0 || nper <= 0 || nper >= per) { r.is_conv = 0; r.g_rank = F.vcu; r.g_count = F.G; r.c_rank = F.vcu; r.c_count = F.G; return r; }
    r.is_conv = rix >= per - nper; r.g_rank = x * (per - nper) + rix; r.g_count = 8 * (per - nper); r.c_rank = x * nper + (rix - (per - nper)); r.c_count = 8 * nper;
    return r;
}
__device__ __forceinline__ void sincos_d(double a, float& s, float& c) {
    const double TWO_PI = 6.283185307179586476925286766559;
    const double k = __builtin_rint(a / TWO_PI);
    const double r = a - k * TWO_PI;
    const double r2 = r * r;
    double ts = r, tc = 1.0, ss = r, cc = 1.0;
#pragma unroll
    for (int i = 1; i <= 14; ++i) { tc = -tc * r2 / (double)((2 * i - 1) * (2 * i)); ts = -ts * r2 / (double)((2 * i) * (2 * i + 1)); cc += tc; ss += ts; }
    s = (float)ss; c = (float)cc;
}

__device__ __forceinline__ void build_moe_tab(Frame& F, int layer, int ntok) {
    int tid_ = (int)threadIdx.x; asm volatile("" : "+v"(tid_));
    if (tid_ < 64) {
        const int cnt = (int)__hip_atomic_load(F.ctl + CW_CNT + (layer * 64 + tid_) * 64, RLX_AGENT);
        F.TAB[66 + tid_] = cnt;
        const int pn = (cnt + 255) >> 8;
        int incl = pn;
#pragma unroll
        for (int o = 1; o < 64; o <<= 1) { const int t = __shfl_up(incl, o); if ((tid_ & 63) >= o) incl += t; }
        F.TAB[tid_ + 1] = incl;
        if (tid_ == 0) F.TAB[0] = 0;
        if (tid_ == 63) F.TAB[65] = incl + ntok / 256;
    }
    LDS_WAIT();
    __syncthreads();
}

struct Args { const float* in[24]; float* out; unsigned char* ws; int ph_lo, ph_hi; };

#ifndef PH_MASK
#define PH_MASK 0x3ffff
#endif
#define IN(k) ((((PH_MASK) >> ((k) >= 14 ? (k) - 6 : (k))) & 1) && lo <= (k) && (k) < hi)
#define SEAM(k) do { if (IN(k) && IN((k) + 1)) xcd_barrier(bar); } while (0)

#define MOD ((float*)(ws + WS_MOD))
#define ROPER ((float*)(ws + WS_ROPE))
#define ROPEC (ROPER + 128 * 64 * 2)
#define L2F ((float*)(ws + WS_L2G))
#define L2B (L2F + 8)
#define RW ((bf16*)(ws + WS_RW))
#define TOKE ((int*)(ws + WS_TOKE))
#define TOKP ((int*)(ws + WS_TOKP))
#define ROWL ((int*)(ws + WS_ROWL))
#define SLOTG ((float*)(ws + WS_SLOTG))
#define WIN ((bf16*)(ws + WS_WIN))
#define WOUT ((bf16*)(ws + WS_WOUT))
#define WPOOL ((bf16*)(ws + WS_WPOOL))
#define HB ((bf16*)(ws + WS_HB))
#define XL ((float*)(ws + WS_XL))
#define R1 ((float*)(ws + WS_R1))
#define KR ((bf16*)(ws + WS_KR))
#define KDTF ((bf16*)(ws + WS_KDTF))
#define KDTB ((bf16*)(ws + WS_KDTB))
#define PQ ((bf16*)(ws + WS_PQ))
#define VS ((bf16*)(ws + WS_VS))
#define UB ((bf16*)(ws + WS_U))
#define GS ((bf16*)(ws + WS_GS))
#define OB ((bf16*)(ws + WS_O))
#define A2 ((bf16*)(ws + WS_A2))
#define ACT ((bf16*)(ws + WS_ACT))
#define YB ((unsigned char*)(ws + WS_Y))
template <int layer>
__device__ __forceinline__ void layer_tail(Frame& F, const Args& args, const int lo, const int hi, const XcdBarrier& bar) {
    unsigned char* const ws = args.ws;
    const int gw = F.vcu * NWAVES + F.wave, NGW = F.G * NWAVES;
    LAS float* scr = (LAS float*)(F.lds + F.wave * 16640);
        const int ntok = NLAT;
        const int pb = layer ? 14 : 8;
        const float* modL = MOD + (size_t)layer * 3 * MODW;
        bf16* W13 = (bf16*)(ws + (layer ? WS_W13_1 : WS_W13_0)); bf16* W2 = (bf16*)(ws + (layer ? WS_W2_1 : WS_W2_0));
        unsigned* cntw = F.ctl + CW_CNT + layer * 64 * 64;

        if (layer == 1) {
            if (IN(12)) {
                for (int it = gw; it < 256 * 8; it += NGW) {
                    const int grow = it >> 3, ch = it & 7, c = ch * 256 + F.lane * 4;
                    const int wdw = 2 << (c >> 9), hw = wdw >> 1;
                    const float* md = MOD + (size_t)(3 + (grow >> 7)) * MODW;
                    const f32x4 sh = *(const f32x4*)(md + c), sc = *(const f32x4*)(md + D + c) + 1.0f;
                    const float* xb = XL + (size_t)grow * 64 * D + c;
                    f32x4 sum = {0.f, 0.f, 0.f, 0.f};
                    for (int j = 0; j < hw; ++j) sum += *(const f32x4*)(xb + (size_t)j * D) * sc + sh;
#pragma unroll 4
                    for (int t = 0; t < 64; ++t) {
                        const int lo2 = (t - hw) < 0 ? 0 : (t - hw), hi2 = (t + hw) > 64 ? 64 : (t + hw);
                        const f32x4 self = *(const f32x4*)(xb + (size_t)t * D) * sc + sh;
                        const f32x4 p = sum * (1.0f / (float)(hi2 - lo2)) - self;
                        u32x2 w; w.x = cvt_pk_bf16(p[0], p[1]); w.y = cvt_pk_bf16(p[2], p[3]);
                        *(u32x2*)(HB + ((size_t)grow * 64 + t) * D + c) = w;
                        if (t + hw < 64) sum += *(const f32x4*)(xb + (size_t)(t + hw) * D) * sc + sh;
                        if (t - hw >= 0) sum -= *(const f32x4*)(xb + (size_t)(t - hw) * D) * sc + sh;
                    }
                }
            }
            SEAM(12);
            if (IN(13)) {
                SchedPool S{(const char*)HB, (const char*)WPOOL, F.G, F.vcu};
                EpiResid E{R1, XL, XL, NLAT, MOD + (size_t)3 * MODW + 2 * D, args.in[15], 1};
                gemm_run<4>(F.lds, Dims{D, 512, 512}, S, E);
            }
            SEAM(13);
        }

        if (IN(pb)) {
            const float* lng = args.in[6] + (size_t)layer * D; const float* lnb = args.in[7] + (size_t)layer * D;
            const bf16* rwh = RW + (size_t)(layer * 2) * NE * D; const bf16* rwl = rwh + (size_t)NE * D;
            const float* rbias = args.in[17] + layer * NE;
            LAS float* PART = (LAS float*)F.lds;
            bf16* HL = (bf16*)(ws + WS_Y);
            const int fr = F.lane & 15, fq = F.lane >> 4;
            const float rb = rbias[F.lane];
            LAS int* LCNT = F.TAB + 512; LAS int* LBASE = F.TAB + 576; LAS int* ASG = F.TAB + 640; LAS float* ASGG = (LAS float*)(F.TAB + 1152);
            const int nblocks = ntok / 16;
            for (int blk0 = F.vcu; blk0 < nblocks; blk0 += 4 * F.G) {
                int nst = 0;
#pragma unroll
                for (int q = 0; q < 4; ++q) nst += (blk0 + q * F.G < nblocks) ? 1 : 0;
                if (F.tid < 64) LCNT[F.tid] = 0;
                f32x4 xa[2][8];
#pragma unroll
                for (int rr = 0; rr < 2; ++rr)
#pragma unroll
                    for (int j = 0; j < 8; ++j) xa[rr][j] = *(const f32x4*)(R1 + (size_t)(blk0 * 16 + 2 * F.wave + rr) * D + j * 256 + F.lane * 4);
                for (int st = 0; st < nst; ++st) {
                    const int r0 = (blk0 + st * F.G) * 16;
                    const float* md = modL + (size_t)(r0 >> 13) * MODW;
                    float rs2[2];
#pragma unroll
                    for (int rr = 0; rr < 2; ++rr) {
                        float sm = 0.f;
#pragma unroll
                        for (int j = 0; j < 8; ++j) sm += (xa[rr][j][0] + xa[rr][j][1]) + (xa[rr][j][2] + xa[rr][j][3]);
                        const float mu = wave_sum(sm) * (1.0f / D); float sq = 0.f;
#pragma unroll
                        for (int j = 0; j < 8; ++j) { xa[rr][j] = xa[rr][j] - mu; sq += (xa[rr][j][0] * xa[rr][j][0] + xa[rr][j][1] * xa[rr][j][1]) + (xa[rr][j][2] * xa[rr][j][2] + xa[rr][j][3] * xa[rr][j][3]); }
                        rs2[rr] = 1.0f / sqrtf(wave_sum(sq) * (1.0f / D) + LN_EPS);
                    }
#pragma unroll
                    for (int rr = 0; rr < 2; ++rr) {
                        const size_t ro = (size_t)(r0 + 2 * F.wave + rr) * D;
#pragma unroll
                        for (int jh = 0; jh < 8; jh += 4) {
                            f32x4 vg[4], vb[4], vsc[4], vsh[4];
#pragma unroll
                            for (int j2 = 0; j2 < 4; ++j2) { const int c = (jh + j2) * 256 + F.lane * 4; vg[j2] = *(const f32x4*)(lng + c); vb[j2] = *(const f32x4*)(lnb + c); vsc[j2] = *(const f32x4*)(md + 4 * D + c); vsh[j2] = *(const f32x4*)(md + 3 * D + c); }
#pragma unroll
                            for (int j2 = 0; j2 < 4; ++j2) {
                                const int j = jh + j2, c = j * 256 + F.lane * 4;
                                const f32x4 y = xa[rr][j] * rs2[rr] * vg[j2] + vb[j2];
                                *(f32x4*)(XL + ro + c) = y;
                                const f32x4 hh = y * (vsc[j2] + 1.0f) + vsh[j2];
                                u32x2 wh, wl;
                                const unsigned b0 = f2bf(hh[0]), b1 = f2bf(hh[1]), b2 = f2bf(hh[2]), b3 = f2bf(hh[3]);
                                wh.x = b0 | (b1 << 16); wh.y = b2 | (b3 << 16);
                                wl.x = cvt_pk_bf16(hh[0] - bf2f(b0), hh[1] - bf2f(b1)); wl.y = cvt_pk_bf16(hh[2] - bf2f(b2), hh[3] - bf2f(b3));
                                *(u32x2*)(HB + ro + c) = wh;
                                *(u32x2*)(HL + ro + c) = wl;
                            }
                        }
                    }
                    {
                        const int nb = (st + 1 < nst) ? blk0 + (st + 1) * F.G : blk0 + st * F.G;
#pragma unroll
                        for (int rr = 0; rr < 2; ++rr)
#pragma unroll
                            for (int j = 0; j < 8; ++j) xa[rr][j] = *(const f32x4*)(R1 + (size_t)(nb * 16 + 2 * F.wave + rr) * D + j * 256 + F.lane * 4);
                    }
                }
                VM_WAIT(); LDS_WAIT(); __syncthreads();
                f32x4 lg[4][4];
#pragma unroll
                for (int st = 0; st < 4; ++st)
#pragma unroll
                    for (int j = 0; j < 4; ++j) lg[st][j] = (f32x4){0.f, 0.f, 0.f, 0.f};
#pragma unroll 2
                for (int ks = 0; ks < 8; ++ks) {
                    const int c = 256 * F.wave + ks * 32 + fq * 8;
                    bf16x8 bh[4], bl[4];
#pragma unroll
                    for (int j = 0; j < 4; ++j) { bh[j] = *(const bf16x8*)(rwh + (size_t)(16 * j + fr) * D + c); bl[j] = *(const bf16x8*)(rwl + (size_t)(16 * j + fr) * D + c); }
#pragma unroll
                    for (int st = 0; st < 4; ++st) {
                        const int bb = (st < nst) ? blk0 + st * F.G : blk0;
                        const size_t ao = (size_t)(bb * 16 + fr) * D + c;
                        const bf16x8 ah = *(const bf16x8*)(HB + ao), al = *(const bf16x8*)(HL + ao);
#pragma unroll
                        for (int j = 0; j < 4; ++j) {
                            lg[st][j] = __builtin_amdgcn_mfma_f32_16x16x32_bf16(ah, bh[j], lg[st][j], 0, 0, 0);
                            lg[st][j] = __builtin_amdgcn_mfma_f32_16x16x32_bf16(al, bh[j], lg[st][j], 0, 0, 0);
                            lg[st][j] = __builtin_amdgcn_mfma_f32_16x16x32_bf16(ah, bl[j], lg[st][j], 0, 0, 0);
                        }
                    }
                }
#pragma unroll
                for (int st = 0; st < 4; ++st)
#pragma unroll
                    for (int j = 0; j < 4; ++j)
#pragma unroll
                        for (int q = 0; q < 4; ++q) PART[F.wave * 4096 + (st * 16 + 4 * fq + q) * 64 + 16 * j + fr] = lg[st][j][q];
                LDS_WAIT(); __syncthreads();
                for (int tt = 0; tt < 8; ++tt) {
                    const int q = 8 * F.wave + tt;
                    if ((q >> 4) >= nst) break;
                    float logit = 0.f;
#pragma unroll
                    for (int w2 = 0; w2 < 8; ++w2) logit += PART[w2 * 4096 + q * 64 + F.lane];
                    const float score = 1.0f / (1.0f + __expf(-logit));
                    const float bsd = score + rb;
                    float m1 = bsd;
                    m1 = fmaxf(m1, __shfl_xor(m1, 1)); m1 = fmaxf(m1, __shfl_xor(m1, 2)); m1 = fmaxf(m1, __shfl_xor(m1, 4));
                    const unsigned long long eqm = __ballot(bsd == m1);
                    const unsigned seg = (unsigned)(eqm >> (F.lane & ~7)) & 0xffu;
                    const int first = __builtin_ctz(seg);
                    float m2 = ((F.lane & 7) == first) ? -__builtin_inff() : bsd;
                    m2 = fmaxf(m2, __shfl_xor(m2, 1)); m2 = fmaxf(m2, __shfl_xor(m2, 2)); m2 = fmaxf(m2, __shfl_xor(m2, 4));
                    const float gs = m1 + m2;
                    int grank = 0; const int myg = F.lane >> 3;
#pragma unroll
                    for (int g2 = 0; g2 < 8; ++g2) { const float o = __shfl(gs, g2 * 8); grank += (o > gs || (o == gs && g2 < myg)) ? 1 : 0; }
                    const float mv = (grank < 4) ? bsd : -__builtin_inff();
                    int rank = 0;
                    unsigned long long gbits = __ballot(grank < 4) & 0x0101010101010101ull;
#pragma unroll 1
                    for (int it = 0; it < 4; ++it) {
                        const int b0 = __builtin_amdgcn_readfirstlane((int)__builtin_ctzll(gbits)); gbits &= gbits - 1;
#pragma unroll
                        for (int j2 = 0; j2 < 8; ++j2) { const int e2 = b0 + j2; const float o = __builtin_bit_cast(float, __builtin_amdgcn_readlane(__builtin_bit_cast(int, mv), e2)); rank += (o > mv || (o == mv && e2 < F.lane)) ? 1 : 0; }
                    }
                    const bool sel = rank < 8;
                    const float ssum = wave_sum(sel ? score : 0.f);
                    if (sel) {
                        const float gate = score / ssum * ROUTED_SCALE;
                        const int local = __hip_atomic_fetch_add(LCNT + F.lane, 1, __ATOMIC_RELAXED, __HIP_MEMORY_SCOPE_WORKGROUP);
                        ASG[q * 8 + rank] = F.lane | (local << 8); ASGG[q * 8 + rank] = gate;
                    }
                }
                LDS_WAIT(); __syncthreads();
                if (F.tid < 64) { const int c = LCNT[F.tid]; LBASE[F.tid] = c ? (int)__hip_atomic_fetch_add(cntw + F.tid * 64, (unsigned)c, RLX_AGENT) : 0; }
                LDS_WAIT(); __syncthreads();
                if (F.tid < nst * 128) {
                    const int q = F.tid >> 3, rank = F.tid & 7, a = ASG[F.tid], e = a & 0xff, pos = LBASE[e] + (a >> 8);
                    const int t = (blk0 + (q >> 4) * F.G) * 16 + (q & 15);
                    ROWL[(size_t)e * CAP + pos] = t; SLOTG[(size_t)t * 8 + rank] = ASGG[F.tid];
                    TOKE[(size_t)t * 8 + rank] = e; TOKP[(size_t)t * 8 + rank] = pos;
                }
                LDS_WAIT(); __syncthreads();
            }
            if (layer == 0 && (CONV_P9 == 0 || CONV_P10 == 0 || F.G % 8 != 0 || CONV_P9 >= F.G / 8)) {
                __syncthreads();
                JobExp dec{args.in[18], args.in[19], args.in[20], args.in[21], args.in[22], args.in[23], (bf16*)(ws + WS_W13_1), (bf16*)(ws + WS_W2_1), 1, 2};
                conv_loop(dec, gw, NGW, dec.count(), scr, F.lane);
            }
        }
        SEAM(pb);

        if (IN(pb + 1)) {
            build_moe_tab(F, layer, ntok);
            const int late = (F.G % 8 == 0 && CONV_P15 > 0 && CONV_P15 < F.G / 8) ? W2_LATE : 0;
            const Roles R = make_roles(F, layer == 0 ? (CONV_P10 > 0 ? CONV_P9 : 0) : (late > 0 ? CONV_P15 : 0));
            if (!R.is_conv) {
                SchedMoE S{F.TAB, (const char*)HB, (const char*)W13, ROWL, 4, D * 2, R.g_count, R.g_rank, 1, W13_E * 2, (size_t)256 * D * 2};
                EpiMoe1 E{ACT};
                gemm_run<5, EpiMoe1, SchedMoE, true>(F.lds, Dims{D, D, D}, S, E);
            } else if (layer == 1) {
                JobExp d1{args.in[18], args.in[19], args.in[20], args.in[21], args.in[22], args.in[23], (bf16*)(ws + WS_W13_1), (bf16*)(ws + WS_W2_1), 1, 1};
                JobFrom dec{d1, d1.count() - late};
                conv_loop(dec, R.c_rank * NWAVES + F.wave, R.c_count * NWAVES, dec.count(), scr, F.lane);
            } else {
                JobExp dec{args.in[18], args.in[19], args.in[20], args.in[21], args.in[22], args.in[23], (bf16*)(ws + WS_W13_1), (bf16*)(ws + WS_W2_1), 1, 0};
                conv_loop(dec, R.c_rank * NWAVES + F.wave, R.c_count * NWAVES, W13_SPLIT < dec.count() ? W13_SPLIT : dec.count(), scr, F.lane);
            }
            __syncthreads();
        }
        SEAM(pb + 1);

        if (IN(pb + 2)) {
            build_moe_tab(F, layer, ntok);
            const Roles R = make_roles(F, (layer == 0 && CONV_P9 > 0) ? CONV_P10 : 0);
            if (!R.is_conv) {
                SchedMoE S{F.TAB, (const char*)ACT, (const char*)W2, ROWL, 8, ED * 2, R.g_count, R.g_rank, 0, W2_E * 2, (size_t)256 * ED * 2};
                EpiMoe2 E{YB};
                gemm_run<6>(F.lds, Dims{ED, ED, ED}, S, E);
            } else {
                JobExp d0{args.in[18], args.in[19], args.in[20], args.in[21], args.in[22], args.in[23], (bf16*)(ws + WS_W13_1), (bf16*)(ws + WS_W2_1), 1, 0};
                JobExp d1{args.in[18], args.in[19], args.in[20], args.in[21], args.in[22], args.in[23], (bf16*)(ws + WS_W13_1), (bf16*)(ws + WS_W2_1), 1, 1};
                JobTail dec{d0, d1, W13_SPLIT < d0.count() ? W13_SPLIT : d0.count()};
                const int late = (F.G % 8 == 0 && CONV_P15 > 0 && CONV_P15 < F.G / 8) ? W2_LATE : 0;
                conv_loop(dec, R.c_rank * NWAVES + F.wave, R.c_count * NWAVES, dec.count() - late, scr, F.lane);
            }
            __syncthreads();
        }
        SEAM(pb + 2);

        if (IN(pb + 3)) {
            build_moe_tab(F, layer, ntok);
            const float* lng = args.in[8] + (size_t)layer * D; const float* lnb = args.in[9] + (size_t)layer * D;
            float* dst = layer ? F.out : XL;
            int eN[8], pN[8]; float gN[8], gC[8];
            u32x2 yv[4][9]; f32x4 xr_[8];
            {
                const int t = (gw < ntok) ? gw : 0, t1 = (t + NGW < ntok) ? t + NGW : t;
                int slot[9];
#pragma unroll
                for (int k = 0; k < 8; ++k) slot[k] = F.TAB[TOKE[(size_t)t * 8 + k]] * 256 + TOKP[(size_t)t * 8 + k];
                slot[8] = F.TAB[64] * 256 + t;
#pragma unroll
                for (int j = 0; j < 4; ++j) {
                    const int c = j * 512 + F.lane * 8;
#pragma unroll
                    for (int k = 0; k < 9; ++k) yv[j][k] = *(const u32x2*)(YB + (size_t)slot[k] * D + c);
                    xr_[2 * j] = *(const f32x4*)(XL + (size_t)t * D + c); xr_[2 * j + 1] = *(const f32x4*)(XL + (size_t)t * D + c + 4);
                }
#pragma unroll
                for (int k = 0; k < 8; ++k) { eN[k] = TOKE[(size_t)t1 * 8 + k]; pN[k] = TOKP[(size_t)t1 * 8 + k]; gN[k] = SLOTG[(size_t)t1 * 8 + k]; gC[k] = SLOTG[(size_t)t * 8 + k]; }
            }
            for (int t = gw; t < ntok; t += NGW) {
                const int v = (t < NLAT) ? (t >> 13) : 2;
                const float* g2 = modL + (size_t)v * MODW + 5 * D;
                f32x4 x[8]; float sm = 0.f;
#pragma unroll
                for (int j = 0; j < 4; ++j) {
                    const int c = j * 512 + F.lane * 8;
                    f32x4 f0 = {0.f, 0.f, 0.f, 0.f}, f1 = {0.f, 0.f, 0.f, 0.f};
#pragma unroll
                    for (int k = 0; k < 9; ++k) {
                        const u32x2 y2 = yv[j][k];
                        const float g = (k < 8) ? gC[k < 8 ? k : 0] : 1.0f;
                        f0[0] += g * __builtin_amdgcn_cvt_f32_fp8((int)y2.x, 0); f0[1] += g * __builtin_amdgcn_cvt_f32_fp8((int)y2.x, 1); f0[2] += g * __builtin_amdgcn_cvt_f32_fp8((int)y2.x, 2); f0[3] += g * __builtin_amdgcn_cvt_f32_fp8((int)y2.x, 3);
                        f1[0] += g * __builtin_amdgcn_cvt_f32_fp8((int)y2.y, 0); f1[1] += g * __builtin_amdgcn_cvt_f32_fp8((int)y2.y, 1); f1[2] += g * __builtin_amdgcn_cvt_f32_fp8((int)y2.y, 2); f1[3] += g * __builtin_amdgcn_cvt_f32_fp8((int)y2.y, 3);
                    }
                    x[2 * j] = xr_[2 * j] * ALPHA + *(const f32x4*)(g2 + c) * (f0 * (1.0f / Y_SCALE));
                    x[2 * j + 1] = xr_[2 * j + 1] * ALPHA + *(const f32x4*)(g2 + c + 4) * (f1 * (1.0f / Y_SCALE));
                    sm += (x[2 * j][0] + x[2 * j][1]) + (x[2 * j][2] + x[2 * j][3]) + (x[2 * j + 1][0] + x[2 * j + 1][1]) + (x[2 * j + 1][2] + x[2 * j + 1][3]);
                }
                const int tn = (t + NGW < ntok) ? t + NGW : t, tnn = (tn + NGW < ntok) ? tn + NGW : tn;
                {
                    int slot[9];
#pragma unroll
                    for (int k = 0; k < 8; ++k) slot[k] = F.TAB[eN[k]] * 256 + pN[k];
                    slot[8] = F.TAB[64] * 256 + tn;
#pragma unroll
                    for (int j = 0; j < 4; ++j) {
                        const int c = j * 512 + F.lane * 8;
#pragma unroll
                        for (int k = 0; k < 9; ++k) yv[j][k] = *(const u32x2*)(YB + (size_t)slot[k] * D + c);
                        xr_[2 * j] = *(const f32x4*)(XL + (size_t)tn * D + c); xr_[2 * j + 1] = *(const f32x4*)(XL + (size_t)tn * D + c + 4);
                    }
#pragma unroll
                    for (int k = 0; k < 8; ++k) { gC[k] = gN[k]; eN[k] = TOKE[(size_t)tnn * 8 + k]; pN[k] = TOKP[(size_t)tnn * 8 + k]; gN[k] = SLOTG[(size_t)tnn * 8 + k]; }
                }
                const float mu = wave_sum(sm) * (1.0f / D); float sq = 0.f;
#pragma unroll
                for (int j = 0; j < 8; ++j) { x[j] = x[j] - mu; sq += (x[j][0] * x[j][0] + x[j][1] * x[j][1]) + (x[j][2] * x[j][2] + x[j][3] * x[j][3]); }
                const float rstd = 1.0f / sqrtf(wave_sum(sq) * (1.0f / D) + LN_EPS);
#pragma unroll
                for (int j = 0; j < 4; ++j) {
                    const int c = j * 512 + F.lane * 8;
                    *(f32x4*)(dst + (size_t)t * D + c) = x[2 * j] * rstd * *(const f32x4*)(lng + c) + *(const f32x4*)(lnb + c);
                    *(f32x4*)(dst + (size_t)t * D + c + 4) = x[2 * j + 1] * rstd * *(const f32x4*)(lng + c + 4) + *(const f32x4*)(lnb + c + 4);
                }
            }
            __syncthreads();
        }
        SEAM(pb + 3);
    }

__global__ void __launch_bounds__(NWAVES * 64, 2) mk_fwd(Args args) {
    extern __shared__ __attribute__((aligned(16))) unsigned char lds_raw[];
    Frame F;
    F.lds = (LAS unsigned char*)lds_raw;
    F.TAB = (LAS int*)(F.lds + LDSCTL_OFF);
    F.MISC = (volatile LAS unsigned*)(F.lds + LDSCTL_OFF + 1024);
    F.tid = threadIdx.x; F.lane = F.tid & 63; F.wave = __builtin_amdgcn_readfirstlane(F.tid >> 6);
    F.G = gridDim.x; { const int bx = blockIdx.x; F.vcu = (F.G % 8 == 0) ? (bx % 8) * (F.G / 8) + bx / 8 : bx; }
    F.ws = args.ws; F.ctl = (unsigned*)(args.ws + WS_CTL); F.out = args.out;
    for (int u = F.tid; u < (LDS_BYTES - LDSCTL_OFF) / 4; u += NWAVES * 64) ((LAS unsigned*)(F.lds + LDSCTL_OFF))[u] = 0u;
    __syncthreads();
    const int lo = args.ph_lo, hi = args.ph_hi;
    XcdBarrier bar; bar.bar = (unsigned*)(F.ctl + CW_BAR); bar.x = 0; bar.st = nullptr;
    if (hi - lo > 1) bar = xcd_barrier_post((unsigned*)(F.ctl + CW_BAR) + (size_t)lo * XCD_BAR_WORDS, F.MISC + 8);
    unsigned char* const ws = args.ws;
    const int gw = F.vcu * NWAVES + F.wave, NGW = F.G * NWAVES;
    LAS float* scr = (LAS float*)(F.lds + F.wave * 16640);

    if (IN(0)) {
        for (int it = F.vcu; it < 2 * 96; it += F.G) {
            const int l = it / 96, c0 = (it % 96) * 128 + 2 * F.lane;
            const float* W = args.in[4] + (size_t)l * D * MODW + c0;
            f32x2 a0 = {0.f, 0.f}, a1 = {0.f, 0.f}, a2 = {0.f, 0.f};
            for (int kc = 256 * F.wave; kc < 256 * F.wave + 256; kc += 64) {
                const float s0 = silu_f(args.in[1][kc + F.lane]), s1 = silu_f(args.in[1][D + kc + F.lane]), s2 = silu_f(args.in[3][kc + F.lane]);
#pragma unroll 16
                for (int kk = 0; kk < 64; ++kk) {
                    const f32x2 w = *(const f32x2*)(W + (size_t)(kc + kk) * MODW);
                    const float b0 = __builtin_bit_cast(float, __builtin_amdgcn_readlane(__builtin_bit_cast(int, s0), kk)), b1 = __builtin_bit_cast(float, __builtin_amdgcn_readlane(__builtin_bit_cast(int, s1), kk)), b2 = __builtin_bit_cast(float, __builtin_amdgcn_readlane(__builtin_bit_cast(int, s2), kk));
                    a0 += w * b0; a1 += w * b1; a2 += w * b2;
                }
            }
            LAS f32x2* red = (LAS f32x2*)F.lds;
            red[(F.wave * 3 + 0) * 64 + F.lane] = a0; red[(F.wave * 3 + 1) * 64 + F.lane] = a1; red[(F.wave * 3 + 2) * 64 + F.lane] = a2;
            LDS_WAIT(); __syncthreads();
            if (F.wave < 3) {
                f32x2 t = {0.f, 0.f};
#pragma unroll
                for (int w2 = 0; w2 < 8; ++w2) t += red[(w2 * 3 + F.wave) * 64 + F.lane];
                const f32x2 bb = *(const f32x2*)(args.in[5] + (size_t)l * MODW + c0);
                *(f32x2*)(MOD + ((size_t)l * 3 + F.wave) * MODW + c0) = t + bb;
            }
            LDS_WAIT(); __syncthreads();
        }
        const int gt = F.vcu * 512 + F.tid, NGT = F.G * 512;
        for (int i = gt; i < 192 * 64; i += NGT) {
            const int j = i & 63, rc = i >> 6;
            double fr = 1.0; for (int q = 0; q < j; ++q) fr *= 0.8659643233600653;
            const double ang = (double)(rc < 128 ? rc : rc - 128) * fr;
            float s, c; sincos_d(ang, s, c);
            float* dst = (rc < 128) ? ROPER + ((size_t)rc * 64 + j) * 2 : ROPEC + ((size_t)(rc - 128) * 64 + j) * 2;
            dst[0] = c; dst[1] = s;
        }
        if (gt < 16) { const float raw = (gt < 8) ? args.in[12][gt] : args.in[13][gt - 8];
            const float v = -log1pf(expf(-raw)) * 1.44269504088896341f; if (gt < 8) L2F[gt] = v; else L2B[gt - 8] = v; }
        for (int i = gt; i < 2 * D * NE; i += NGT) {
            const int l = i / (D * NE), r = i % (D * NE), k = r / NE, e = r % NE;
            const float w = args.in[16][i]; const unsigned whi = f2bf(w); const float wlo = w - bf2f(whi);
            RW[((size_t)(l * 2 + 0) * NE + e) * D + k] = (bf16)whi; RW[((size_t)(l * 2 + 1) * NE + e) * D + k] = (bf16)f2bf(wlo);
        }
        { JobP0 dec{args.in[10], args.in[11], args.in[14], WIN, WOUT, WPOOL}; conv_loop(dec, gw, NGW, JobP0::N, scr, F.lane); }
        if (CONV_P2 == 0 || F.G % 8 != 0 || CONV_P2 >= F.G / 8) { JobExp dec{args.in[18], args.in[19], args.in[20], args.in[21], args.in[22], args.in[23], (bf16*)(ws + WS_W13_0), (bf16*)(ws + WS_W2_0), 0, 2}; conv_loop(dec, gw, NGW, dec.count(), scr, F.lane); }
    }
    SEAM(0);

    if (IN(1)) {
        for (int r = gw; r < NTOK0; r += NGW) {
            const float* xr = (r < NLAT) ? args.in[0] + (size_t)r * D : args.in[2] + (size_t)(r - NLAT) * D;
            const int v = (r < NLAT) ? (r >> 13) : 2;
            const float* md = MOD + (size_t)v * MODW;
#pragma unroll
            for (int j = 0; j < 4; ++j) {
                const int c = j * 512 + F.lane * 8;
                const f32x4 x0 = *(const f32x4*)(xr + c), x1 = *(const f32x4*)(xr + c + 4);
                const f32x4 h0 = *(const f32x4*)(md + c), h1 = *(const f32x4*)(md + c + 4), s0 = *(const f32x4*)(md + D + c), s1 = *(const f32x4*)(md + D + c + 4);
                *(u32x4*)(HB + (size_t)r * D + c) = pack8(x0 * (s0 + 1.0f) + h0, x1 * (s1 + 1.0f) + h1);
            }
        }
    }
    SEAM(1);

    if (IN(2)) {
        const Roles R = make_roles(F, CONV_P2);
        if (!R.is_conv) {
            SchedWin S{(const char*)HB, (const char*)WIN, R.g_count, R.g_rank};
            EpiWin E{KR, KDTF, KDTB, PQ, VS, GS, ROPER, ROPEC, L2F, L2B};
            gemm_run<0>(F.lds, Dims{D, D, D}, S, E);
        } else {
            JobExp dec{args.in[18], args.in[19], args.in[20], args.in[21], args.in[22], args.in[23], (bf16*)(ws + WS_W13_0), (bf16*)(ws + WS_W2_0), 0, 2};
            conv_loop(dec, R.c_rank * NWAVES + F.wave, R.c_count * NWAVES, dec.count(), scr, F.lane);
        }
    }
    SEAM(2);

    if (IN(3)) {
        SchedRet3 S{(const char*)PQ, (const char*)KR, (const char*)VS, (const char*)KDTF, (size_t)(WS_KDTB - WS_KDTF), F.G, F.vcu};
        EpiRet3 E{PQ, UB, L2F, L2B};
        gemm_run<1>(F.lds, Dims{768, 256, 256}, S, E);
    }
    SEAM(3);

    if (IN(4)) {
        const int gt = F.vcu * 512 + F.tid, NGT = F.G * 512;
        for (int it = gt; it < 16 * 2 * 512 * 32; it += NGT) {
            const int dkc = it & 31, dv = (it >> 5) & 511, dir = (it >> 14) & 1, bh = it >> 15, b = bh >> 3, h = bh & 7;
            const float dec = exp2f((dir ? L2B[h] : L2F[h]) * 256.0f);
            float s[8];
#pragma unroll
            for (int j = 0; j < 8; ++j) s[j] = 0.f;
            for (int st = 0; st < 33; ++st) {
                const int pm = (st == 0) ? 64 + b : b * 32 + (dir ? 32 - st : st - 1);
                const size_t idx = (size_t)pm * 8 + h;
                u32x4 w; w.x = cvt_pk_bf16(s[0], s[1]); w.y = cvt_pk_bf16(s[2], s[3]); w.z = cvt_pk_bf16(s[4], s[5]); w.w = cvt_pk_bf16(s[6], s[7]);
                *(u32x4*)(VS + idx * VS_E + (size_t)dv * 768 + 256 + dir * 256 + dkc * 8) = w;
                if (st == 32) break;
                const u32x4 uv = *(const u32x4*)(UB + (idx * 2 + dir) * U_E + (size_t)dv * 256 + dkc * 8);
                s[0] = s[0] * dec + bf2f(uv.x & 0xffffu); s[1] = s[1] * dec + bf2f(uv.x >> 16);
                s[2] = s[2] * dec + bf2f(uv.y & 0xffffu); s[3] = s[3] * dec + bf2f(uv.y >> 16);
                s[4] = s[4] * dec + bf2f(uv.z & 0xffffu); s[5] = s[5] * dec + bf2f(uv.z >> 16);
                s[6] = s[6] * dec + bf2f(uv.w & 0xffffu); s[7] = s[7] * dec + bf2f(uv.w >> 16);
            }
        }
    }
    SEAM(4);

    if (IN(5)) {
        SchedO S{(const char*)PQ, (const char*)VS, F.G, F.vcu};
        EpiO E{OB};
        gemm_run<2>(F.lds, Dims{768, 768, 768}, S, E);
    }
    SEAM(5);

    if (IN(6)) {
        for (int it0 = gw; it0 < NLAT * NH; it0 += 4 * NGW) {
            u32x4 ov[4], gv[4]; size_t off[4];
#pragma unroll
            for (int q = 0; q < 4; ++q) { const int it = it0 + q * NGW;
                const int itc = it < NLAT * NH ? it : it0;
                off[q] = (size_t)(itc >> 3) * VD + (size_t)(itc & 7) * 512 + F.lane * 8;
                ov[q] = *(const u32x4*)(OB + off[q]); gv[q] = *(const u32x4*)(GS + off[q]); }
            u32x4 wq[4];
#pragma unroll
            for (int q = 0; q < 4; ++q) {
                float o[8], g[8];
                o[0] = bf2f(ov[q].x & 0xffffu); o[1] = bf2f(ov[q].x >> 16); o[2] = bf2f(ov[q].y & 0xffffu); o[3] = bf2f(ov[q].y >> 16);
                o[4] = bf2f(ov[q].z & 0xffffu); o[5] = bf2f(ov[q].z >> 16); o[6] = bf2f(ov[q].w & 0xffffu); o[7] = bf2f(ov[q].w >> 16);
                g[0] = bf2f(gv[q].x & 0xffffu); g[1] = bf2f(gv[q].x >> 16); g[2] = bf2f(gv[q].y & 0xffffu); g[3] = bf2f(gv[q].y >> 16);
                g[4] = bf2f(gv[q].z & 0xffffu); g[5] = bf2f(gv[q].z >> 16); g[6] = bf2f(gv[q].w & 0xffffu); g[7] = bf2f(gv[q].w >> 16);
#pragma unroll
                for (int j = 0; j < 8; ++j) g[j] = silu_f(g[j]);
                float sm = 0.f;
#pragma unroll
                for (int j = 0; j < 8; ++j) sm += o[j];
                const float mu = wave_sum(sm) * (1.0f / 512.0f);
                float sq = 0.f;
#pragma unroll
                for (int j = 0; j < 8; ++j) { o[j] -= mu; sq += o[j] * o[j]; }
                const float rstd = 1.0f / sqrtf(wave_sum(sq) * (1.0f / 512.0f) + LN_EPS);
                wq[q].x = cvt_pk_bf16(o[0] * rstd * g[0], o[1] * rstd * g[1]); wq[q].y = cvt_pk_bf16(o[2] * rstd * g[2], o[3] * rstd * g[3]);
                wq[q].z = cvt_pk_bf16(o[4] * rstd * g[4], o[5] * rstd * g[5]); wq[q].w = cvt_pk_bf16(o[6] * rstd * g[6], o[7] * rstd * g[7]);
            }
#pragma unroll
            for (int q = 0; q < 4; ++q) if (it0 + q * NGW < NLAT * NH) *(u32x4*)(A2 + off[q]) = wq[q];
        }
    }
    SEAM(6);

    if (IN(7)) {
        SchedDense S{(const char*)A2, (const char*)WOUT, VD, VD, 64, D / 256, 64 * (D / 256), F.G, (int)blockIdx.x};
        EpiResid E{R1, args.in[0], args.in[2], NLAT, MOD + 2 * D, nullptr, 0};
        gemm_run<3>(F.lds, Dims{VD, VD, VD}, S, E);
    }
    SEAM(7);

    layer_tail<0>(F, args, lo, hi, bar);
    layer_tail<1>(F, args, lo, hi, bar);
}

extern "C" void kernel_launch(void* const* d_in, const int* in_sizes, int n_in, void* d_out, int out_size, void* d_ws, size_t ws_size, hipStream_t stream) {
    static int grid = 0;
    if (grid == 0) {
        if (n_in != 24 || in_sizes[0] != NLAT * D || out_size != NLAT * D || ws_size < WS_END) {
            fprintf(stderr, "kernel_launch: unexpected problem (n_in %d, in0 %d, out %d, ws %zu; need ws >= %zu); nothing launched\n", n_in, n_in > 0 ? in_sizes[0] : -1, out_size, ws_size, (size_t)WS_END);
            grid = -1; return; }
        int dev = 0, cus = 0, per_cu = 0;
        if (hipGetDevice(&dev) != hipSuccess || hipDeviceGetAttribute(&cus, hipDeviceAttributeMultiprocessorCount, dev) != hipSuccess) { grid = -1; return; }
        if (hipFuncSetAttribute((const void*)mk_fwd, hipFuncAttributeMaxDynamicSharedMemorySize, LDS_BYTES) != hipSuccess) { fprintf(stderr, "kernel_launch: hipFuncSetAttribute failed\n"); grid = -1; return; }
        if (hipOccupancyMaxActiveBlocksPerMultiprocessor(&per_cu, (const void*)mk_fwd, NWAVES * 64, LDS_BYTES) != hipSuccess || per_cu < 1) {
            fprintf(stderr, "kernel_launch: occupancy query reports %d workgroups per CU\n", per_cu); }
        (void)hipGetLastError();
        grid = cus;
    }
    if (grid < 0) return;
    if (hipMemsetAsync((char*)d_ws + WS_CTL, 0, CTL_ZERO_BYTES, stream) != hipSuccess) { fprintf(stderr, "kernel_launch: memset failed\n"); return; }
    Args a{};
    for (int i = 0; i < 24; ++i) a.in[i] = (const float*)d_in[i];
    a.out = (float*)d_out; a.ws = (unsigned char*)d_ws;
#if MK_PER_PHASE
    for (int p = 0; p < PH_LIMIT; ++p) { a.ph_lo = p; a.ph_hi = p + 1; hipLaunchKernelGGL(mk_fwd, dim3(grid), dim3(NWAVES * 64), LDS_BYTES, stream, a); }
#else
    a.ph_lo = 0; a.ph_hi = NPH; hipLaunchKernelGGL(mk_fwd, dim3(grid), dim3(NWAVES * 64), LDS_BYTES, stream, a);
#endif
    const hipError_t le = hipPeekAtLastError();
    if (le != hipSuccess) fprintf(stderr, "kernel_launch: launch failed: %s\n", hipGetErrorName(le));
}
```
